# Optimizing an MI355X kernel written in HIP

```python
import math
import jax, jax.numpy as jnp
from jax import lax
import numpy as np

D_MODEL = 2048
BATCH = 2
SEQ = 4096
DEPTH = 1
DEC_BATCH = 8
DEC_SEQ = 4
PAST_LEN = 16384
PAGE_SIZE = 128

HEAD_DIM = 128
N_MIX_HEADS = D_MODEL // HEAD_DIM
GMLP_GROUPS = N_MIX_HEADS // 4
GMLP_GW = HEAD_DIM
GMLP_W = GMLP_GROUPS * GMLP_GW
DIL_WINDOWS = (128, 512, 2048)
DIL_RATES = (1, 4, 16)
N_DIL = len(DIL_WINDOWS)
H_PER = (N_MIX_HEADS - GMLP_GROUPS) // N_DIL
N_ATTN_HEADS = N_DIL * H_PER
ATTN_W = N_ATTN_HEADS * HEAD_DIM
D_IN = 3 * ATTN_W + 2 * GMLP_W
D_OUT_MIX = H_PER * HEAD_DIM + GMLP_W
CHUNK = 128
QBLK = 128
D_FF = 4 * D_MODEL
NUM_BUCKETS = 32
MAX_EXACT = NUM_BUCKETS // 2
REL_MAX_DIST = 2048
EPS = 1e-6

kernel_name = "hymba_gmlp_dilated_window_decoder_step"


def rms_norm(x, g):
    xf = x.astype(jnp.float32)
    y = xf * lax.rsqrt(jnp.mean(xf * xf, axis=-1, keepdims=True) + EPS)
    return (y * g.astype(jnp.float32)).astype(x.dtype)


def t5_bucket(dist):
    is_small = dist < MAX_EXACT
    d = jnp.maximum(dist, 1).astype(jnp.float32)
    large = MAX_EXACT + (jnp.log(d / MAX_EXACT) / math.log(REL_MAX_DIST / MAX_EXACT)
                         * (NUM_BUCKETS - MAX_EXACT)).astype(jnp.int32)
    large = jnp.minimum(large, NUM_BUCKETS - 1)
    return jnp.where(is_small, dist, large)


def dilated_attn_prompt(q, k, v, bias_tab, dil, nk):
    B, S, H, Dh = q.shape
    span = dil * QBLK
    Sp = -(-S // span) * span
    M = Sp // dil
    nb = M // QBLK

    def to_blocks(a):
        a = jnp.pad(a, ((0, 0), (0, Sp - S), (0, 0), (0, 0)))
        return a.reshape(B, M, dil, H, Dh).transpose(0, 2, 1, 3, 4).reshape(B, dil, nb, QBLK, H, Dh)

    def band(a):
        prev = jnp.pad(a[:, :, :-1], ((0, 0), (0, 0), (1, 0), (0, 0), (0, 0), (0, 0)))
        return jnp.concatenate([prev, a], axis=3)

    qb = to_blocks(q)
    kband = band(to_blocks(k))
    vband = band(to_blocks(v))
    i = jnp.arange(QBLK)[:, None]
    j = jnp.arange(2 * QBLK)[None, :]
    sub = i + QBLK - j
    blk = jnp.arange(nb)[:, None, None]
    valid = (sub >= 0) & (sub <= nk) & (blk * QBLK + j - QBLK >= 0)
    bias = bias_tab[t5_bucket(jnp.clip(sub, 0, nk) * dil)]
    bias = bias.astype(jnp.float32).transpose(2, 0, 1)
    s = jnp.einsum('brnqhd,brnkhd->brnhqk', qb, kband,
                   preferred_element_type=jnp.float32) * (HEAD_DIM ** -0.5) + bias
    s = jnp.where(valid[None, None, :, None], s, -jnp.inf)
    m = jnp.max(s, axis=-1, keepdims=True)
    p = jnp.exp(s - m)
    den = jnp.sum(p, axis=-1, keepdims=True)
    o = jnp.einsum('brnhqk,brnkhd->brnqhd', p / den, vband.astype(jnp.float32))
    lse = (m + jnp.log(den))[..., 0]
    o = o.reshape(B, dil, M, H, Dh).transpose(0, 2, 1, 3, 4).reshape(B, Sp, H, Dh)[:, :S]
    lse = lse.transpose(0, 1, 2, 4, 3).reshape(B, dil, M, H).transpose(0, 2, 1, 3).reshape(B, Sp, H)[:, :S]
    return o, lse


def dilated_attn_sample(q, k_new, v_new, kv_cache, bias_tab, dil, nk):
    L = kv_cache.shape[2]
    T = q.shape[1]
    k_all = jnp.concatenate([kv_cache[:, 0], k_new], axis=1)
    v_all = jnp.concatenate([kv_cache[:, 1], v_new], axis=1)
    steps = jnp.arange(nk + 1)
    idx = L + jnp.arange(T)[:, None] - steps[None, :] * dil
    valid = idx >= 0
    idxc = jnp.maximum(idx, 0)
    kg = k_all[:, idxc]
    vg = v_all[:, idxc]
    bias = bias_tab[t5_bucket(steps * dil)].astype(jnp.float32).T
    s = jnp.einsum('bthd,btkhd->bthk', q, kg,
                   preferred_element_type=jnp.float32) * (HEAD_DIM ** -0.5) + bias
    s = jnp.where(valid[None, :, None, :], s, -jnp.inf)
    m = jnp.max(s, axis=-1, keepdims=True)
    p = jnp.exp(s - m)
    den = jnp.sum(p, axis=-1, keepdims=True)
    o = jnp.einsum('bthk,btkhd->bthd', p / den, vg.astype(jnp.float32))
    return o, (m + jnp.log(den))[..., 0]


def spatial_gate(u, g, w_s, b_s):
    B, S, _ = u.shape
    c = min(S, CHUNK)
    n = S // c
    wm = w_s[:, :c, :c] * jnp.tril(jnp.ones((c, c), w_s.dtype))
    gb = g.reshape(B, n, c, GMLP_GROUPS, GMLP_GW)
    mixed = jnp.einsum('gts,bnsgd->bntgd', wm, gb) + b_s[:, :c].T[None, None, :, :, None]
    return u * mixed.reshape(B, S, GMLP_W)


def decoder_layer(x, caches, norm_mix, w_in, q_norm, k_norm, gmlp_v_norm, gmlp_w, gmlp_b,
                  w_out, norm_ffn, w_up, w_down, rel_bias):
    B, S, _ = x.shape
    h = rms_norm(x, norm_mix)
    z = h @ w_in
    q = rms_norm(z[..., :ATTN_W].reshape(B, S, N_DIL, H_PER, HEAD_DIM), q_norm)
    k = rms_norm(z[..., ATTN_W:2 * ATTN_W].reshape(B, S, N_DIL, H_PER, HEAD_DIM), k_norm)
    v = z[..., 2 * ATTN_W:3 * ATTN_W].reshape(B, S, N_DIL, H_PER, HEAD_DIM)
    u = jax.nn.gelu(z[..., 3 * ATTN_W:3 * ATTN_W + GMLP_W], approximate=False)
    g = rms_norm(jax.nn.gelu(z[..., 3 * ATTN_W + GMLP_W:], approximate=False), gmlp_v_norm)

    outs, lses, new_kv = [], [], []
    for gi in range(N_DIL):
        win, dil = DIL_WINDOWS[gi], DIL_RATES[gi]
        nk = win // dil
        bias_g = rel_bias[:, gi * H_PER:(gi + 1) * H_PER]
        qg, kg, vg = q[:, :, gi], k[:, :, gi], v[:, :, gi]
        if caches is None:
            o, lse = dilated_attn_prompt(qg, kg, vg, bias_g, dil, nk)
            keep = min(win, S)
            new_kv.append(jnp.stack([kg[:, S - keep:], vg[:, S - keep:]], axis=1))
        else:
            o, lse = dilated_attn_sample(qg, kg, vg, caches[gi], bias_g, dil, nk)
            new_kv.append(jnp.stack([kg, vg], axis=1))
        outs.append(o)
        lses.append(lse)
    alpha = jax.nn.softmax(jnp.stack(lses, axis=0), axis=0)
    attn = jnp.einsum('gbsh,gbshd->bshd', alpha, jnp.stack(outs, axis=0))
    attn = attn.reshape(B, S, H_PER * HEAD_DIM).astype(x.dtype)
    gm = spatial_gate(u, g, gmlp_w, gmlp_b)
    x = x + jnp.concatenate([attn, gm], axis=-1) @ w_out
    h2 = rms_norm(x, norm_ffn)
    x = x + jnp.square(jax.nn.relu(h2 @ w_up)) @ w_down
    return x, new_kv, g


def setup_inputs(seed: int = 0) -> dict:
    key = jax.random.key(seed)
    ks = jax.random.split(key, 20)
    f32 = jnp.float32

    def nrm(k, shape, scale):
        return jax.random.normal(k, shape, f32) * scale

    def gain(k, shape):
        return 1.0 + nrm(k, shape, 0.02)

    return {
        "x_prompt": nrm(ks[0], (BATCH, SEQ, D_MODEL), 1.0),
        "x_sample": nrm(ks[1], (DEC_BATCH, DEC_SEQ, D_MODEL), 1.0),
        "cache_kv_w128": nrm(ks[2], (DEPTH, DEC_BATCH, 2, min(DIL_WINDOWS[0], PAST_LEN), H_PER, HEAD_DIM), 1.0),
        "cache_kv_w512": nrm(ks[3], (DEPTH, DEC_BATCH, 2, min(DIL_WINDOWS[1], PAST_LEN), H_PER, HEAD_DIM), 1.0),
        "cache_kv_w2048": nrm(ks[4], (DEPTH, DEC_BATCH, 2, min(DIL_WINDOWS[2], PAST_LEN), H_PER, HEAD_DIM), 1.0),
        "norm_mix": gain(ks[5], (DEPTH, D_MODEL)),
        "w_in": nrm(ks[6], (DEPTH, D_MODEL, D_IN), D_MODEL ** -0.5),
        "q_norm": gain(ks[7], (DEPTH, HEAD_DIM)),
        "k_norm": gain(ks[8], (DEPTH, HEAD_DIM)),
        "rel_bias": nrm(ks[9], (NUM_BUCKETS, N_ATTN_HEADS), 0.5),
        "gmlp_v_norm": gain(ks[10], (DEPTH, GMLP_W)),
        "gmlp_w": nrm(ks[11], (DEPTH, GMLP_GROUPS, CHUNK, CHUNK), CHUNK ** -0.5),
        "gmlp_b": gain(ks[12], (DEPTH, GMLP_GROUPS, CHUNK)),
        "w_out": nrm(ks[13], (DEPTH, D_OUT_MIX, D_MODEL), D_OUT_MIX ** -0.5),
        "norm_ffn": gain(ks[14], (DEPTH, D_MODEL)),
        "w_up": nrm(ks[15], (DEPTH, D_MODEL, D_FF), D_MODEL ** -0.5),
        "w_down": nrm(ks[16], (DEPTH, D_FF, D_MODEL), D_FF ** -0.5),
    }


def reference(x_prompt, x_sample, cache_kv_w128, cache_kv_w512, cache_kv_w2048, norm_mix, w_in,
              q_norm, k_norm, rel_bias, gmlp_v_norm, gmlp_w, gmlp_b, w_out, norm_ffn, w_up, w_down):
    caches = (cache_kv_w128, cache_kv_w512, cache_kv_w2048)
    yp, ys = x_prompt, x_sample
    new_p = [[] for _ in range(N_DIL)]
    new_s = [[] for _ in range(N_DIL)]
    gv = []
    for l in range(DEPTH):
        params = (norm_mix[l], w_in[l], q_norm[l], k_norm[l], gmlp_v_norm[l], gmlp_w[l], gmlp_b[l],
                  w_out[l], norm_ffn[l], w_up[l], w_down[l], rel_bias)
        yp, kv_p, _ = decoder_layer(yp, None, *params)
        ys, kv_s, g_s = decoder_layer(ys, (caches[0][l], caches[1][l], caches[2][l]), *params)
        for gi in range(N_DIL):
            new_p[gi].append(kv_p[gi])
            new_s[gi].append(kv_s[gi])
        gv.append(g_s)
    kv_w128_prompt = jnp.stack(new_p[0], axis=0)
    kv_w512_prompt = jnp.stack(new_p[1], axis=0)
    kv_w2048_prompt = jnp.stack(new_p[2], axis=0)
    kv_w128_sample = jnp.stack(new_s[0], axis=0)
    kv_w512_sample = jnp.stack(new_s[1], axis=0)
    kv_w2048_sample = jnp.stack(new_s[2], axis=0)
    gmlp_v_sample = jnp.stack(gv, axis=0)
    return (yp, ys, kv_w128_prompt, kv_w512_prompt, kv_w2048_prompt,
            kv_w128_sample, kv_w512_sample, kv_w2048_sample, gmlp_v_sample)
```

```cpp
#include <hip/hip_runtime.h>
#include <cstdio>
#include <cstdint>

#ifndef MK_N_LAUNCHES
#define MK_N_LAUNCHES 1
#endif
#ifndef PROBE_LO
#define PROBE_LO -1
#define PROBE_HI -1
#endif
#ifndef PROBE_SKIP
#define PROBE_SKIP 0
#endif

constexpr int DM = 2048, SEQ = 4096, NB = 2, MP = NB * SEQ  , MS = 32  , MV = MP + MS  , MPAD = 8448  ;
constexpr int DIN = 5632, DMIX = 1024, DFF = 8192;
constexpr int ZQ = 0, ZK = 1536, ZV = 3072, ZU = 4608, ZG = 5120;
constexpr float EPS = 1e-6f;
constexpr float LOG2E = 1.4426950408889634f;
constexpr float QSCALE = 0.08838834764831845f * 1.4426950408889634f;
constexpr size_t OUT_Y = 0;
constexpr size_t OUT_KVP0 = (size_t)MV * DM;
constexpr size_t OUT_KVP1 = OUT_KVP0 + 2 * 2 * 128 * 512;
constexpr size_t OUT_KVP2 = OUT_KVP1 + 2 * 2 * 512 * 512;
constexpr size_t OUT_KVS0 = OUT_KVP2 + 2 * 2 * 2048 * 512;
constexpr size_t OUT_GV = OUT_KVS0 + 3 * 32768;
constexpr size_t OUT_END = OUT_GV + 16384;
static_assert(OUT_END == 22462464, "d_out map");

constexpr size_t MiB = 1u << 20;
constexpr size_t WS_CTL = 0, CTL_ZERO_BYTES = 64 * 1024;
constexpr size_t WS_SSQG = 1 * MiB;
constexpr size_t WS_LSE = WS_SSQG + (size_t)MPAD * 2 * 4;
constexpr size_t WS_SSQ2 = WS_LSE + (size_t)3 * MPAD * 4 * 4;
constexpr size_t WS_SSQ2S = WS_SSQ2 + (size_t)MPAD * 8 * 4;
static_assert(WS_SSQ2S + 32 * 128 * 4 <= 2 * MiB, "small arrays");
constexpr size_t WS_WIN = 2 * MiB, WS_WOUT = 24 * MiB, WS_WUP = 28 * MiB, WS_WDN = 60 * MiB;
constexpr size_t WS_H = 92 * MiB;
constexpr size_t WS_ACT = 125 * MiB;
constexpr size_t WS_Z = WS_ACT;
constexpr size_t WS_OG = WS_Z + (size_t)MPAD * DIN * 2;
constexpr size_t WS_MIX = WS_OG + (size_t)3 * MPAD * 512 * 2;
constexpr size_t WS_END = WS_ACT + (size_t)MPAD * DFF * 2;
static_assert(WS_MIX + (size_t)MPAD * DMIX * 2 <= WS_END && WS_H + (size_t)MPAD * DM * 2 <= WS_ACT && WS_WDN + (size_t)DM * DFF * 2 <= WS_H && WS_WIN + (size_t)DIN * DM * 2 <= WS_WOUT, "d_ws map");
constexpr int CW_BAR = 4096, CW_QUEUE = 2048;

constexpr int RING_BYTES = 131072;
constexpr int XL_OFF = RING_BYTES;
constexpr int XL_BYTES = 12288;
constexpr int MISC_OFF = XL_OFF + XL_BYTES;
constexpr int LDS_BYTES = 147456;
static_assert(MISC_OFF + 128 <= LDS_BYTES, "LDS map");

#define GAS __attribute__((address_space(1)))
#define LAS __attribute__((address_space(3)))
typedef unsigned short bf16_t;
typedef short bf16x8 __attribute__((ext_vector_type(8)));
typedef short s16x4 __attribute__((ext_vector_type(4)));
typedef float f32x4 __attribute__((ext_vector_type(4)));
typedef float f32x2 __attribute__((ext_vector_type(2)));
typedef unsigned u32x4 __attribute__((ext_vector_type(4)));
typedef unsigned u32x2 __attribute__((ext_vector_type(2)));

__device__ __forceinline__ unsigned cvt_pk_bf16(float lo, float hi) { unsigned r; asm volatile("v_cvt_pk_bf16_f32 %0, %1, %2" : "=v"(r) : "v"(lo), "v"(hi)); return r; }
__device__ __forceinline__ float bf_lo(unsigned w) { return __uint_as_float(w << 16); }
__device__ __forceinline__ float bf_hi(unsigned w) { return __uint_as_float(w & 0xffff0000u); }
__device__ __forceinline__ float dot4(f32x4 a) { return (a.x * a.x + a.y * a.y) + (a.z * a.z + a.w * a.w); }
__device__ __forceinline__ float wave_sum(float v) {
#pragma unroll
    for (int o = 1; o < 64; o <<= 1) v += __shfl_xor(v, o);
    return v;
}
__device__ __forceinline__ float wave_max(float v) {
#pragma unroll
    for (int o = 1; o < 64; o <<= 1) v = fmaxf(v, __shfl_xor(v, o));
    return v;
}
#define EPI_BAR() do { asm volatile("s_waitcnt lgkmcnt(0)" ::: "memory"); __builtin_amdgcn_s_barrier(); asm volatile("" ::: "memory"); } while (0)

namespace pg8 {
#define PG8_LAS __attribute__((address_space(3)))
constexpr int BM = 256, BK = 64, HALF = 128, HTB = HALF * BK * 2, STAGE_BYTES = 8 * HTB, NXCD = 8, WGM = 8;
__host__ __device__ __forceinline__ int lds_byte(int r, int c) { const int st = (r >> 4) * 2 + (c >> 5), rr = r & 15, cc = c & 31, ob = rr * 64 + cc * 2; return st * 1024 + (ob ^ (((ob >> 9) & 1) << 5)); }
__host__ __device__ __forceinline__ void stage_rc(int b, int& R, int& C) { const int st = b / 1024, sb = b % 1024, swz = sb ^ (((sb >> 9) & 1) << 5); R = (st >> 1) * 16 + swz / 64; C = (st & 1) * 32 + (swz % 64) / 2; }
__host__ __device__ __forceinline__ int perm32(int rho) { const int n = rho >> 4, i = rho & 15; return 8 * (i >> 2) + 4 * n + (i & 3); }

struct Unit { int pm, pn; };
struct Gemm { const bf16_t* A; const bf16_t* Bt; int M, N, K; };

struct StaticOrder {
    int nM, nN, nwg, G, c;
    __host__ __device__ void init(int M, int N, int G_, int c_) { nM = M / BM; nN = N / BM; nwg = nM * nN; G = G_; c = c_; }
    __host__ __device__ bool next(int i, Unit& u) const {
        const long L = (long)i * G + c; if (L >= nwg) return false;
        int wgid = (int)L; { const int q = nwg / NXCD, r = nwg % NXCD, xcd = wgid % NXCD, off = wgid / NXCD; wgid = (xcd < r ? xcd * (q + 1) : r * (q + 1) + (xcd - r) * q) + off; }
        const int nig = WGM * nN, gid = wgid / nig, fm = gid * WGM, gsz = (nM - fm) < WGM ? (nM - fm) : WGM;
        u.pm = fm + ((wgid % nig) % gsz); u.pn = (wgid % nig) / gsz; return true;
    }
    __device__ __forceinline__ void a_ready(const Unit&) const {}
    __device__ __forceinline__ void done(const Unit&) const {}
};

__device__ __forceinline__ f32x2 gelu_pk(f32x2 v) {
    const f32x2 av = __builtin_elementwise_abs(v), d = av * 0.2316418882f + 1.0f;
    f32x2 t; t.x = __builtin_amdgcn_rcpf(d.x); t.y = __builtin_amdgcn_rcpf(d.y);
    f32x2 q = t * 0.5307027145f + (-0.7265760135f); q = q * t + 0.7107068705f; q = q * t + (-0.142248368f); q = q * t + 0.127414796f; q = q * t;
    const f32x2 s = (v * v) * (-0.72134752044f);
    f32x2 e; e.x = __builtin_amdgcn_exp2f(s.x); e.y = __builtin_amdgcn_exp2f(s.y);
    const f32x2 m = v * (q * e), r = v - m;
    f32x2 o; o.x = v.x < 0.f ? m.x : r.x; o.y = v.y < 0.f ? m.y : r.y; return o;
}
__device__ __forceinline__ f32x4 gelu4(f32x4 v) { const f32x2 a = gelu_pk((f32x2){v.x, v.y}), b = gelu_pk((f32x2){v.z, v.w}); return (f32x4){a.x, a.y, b.x, b.y}; }
__device__ __forceinline__ u32x4 pack8(f32x4 v0, f32x4 v1) { u32x4 w; w.x = cvt_pk_bf16(v0.x, v0.y); w.y = cvt_pk_bf16(v0.z, v0.w); w.z = cvt_pk_bf16(v1.x, v1.y); w.w = cvt_pk_bf16(v1.z, v1.w); return w; }

__device__ __forceinline__ float* kv_dst(float* out, int row, int gi, int kv, int hh) {
    if (row < MP) {
        const int keep = 128 << (2 * gi), b = row >> 12, t = row & 4095, pos = t - (SEQ - keep);
        if (pos < 0) return nullptr;
        const size_t base = gi == 0 ? OUT_KVP0 : (gi == 1 ? OUT_KVP1 : OUT_KVP2);
        return out + base + ((size_t)((b * 2 + kv) * keep + pos) * 4 + hh) * 128;
    }
    const int j = row - MP; if (j >= MS) return nullptr;
    return out + OUT_KVS0 + (size_t)gi * 32768 + ((size_t)(((j >> 2) * 2 + kv) * 4 + (j & 3)) * 4 + hh) * 128;
}

struct EpiZ {
    static constexpr bool PERM = true, AFTER_DRAIN = false;
    bf16_t* Z; float* out; const float* qn; const float* kn; float* ssqg;
    __device__ __forceinline__ void operator()(f32x4 (&acc)[2][2][4][2], const Unit& u, int wr, int wc, int fr, int fq, PG8_LAS unsigned char* xl) const {
        const int pn = u.pn, rowl0 = wr * 64 + fr, cl0 = wc * 32 + 8 * fq;
        PG8_LAS float* P = (PG8_LAS float*)xl;
        if (pn < 12) {
            const bool isq = pn < 6;
#pragma unroll
            for (int ai = 0; ai < 2; ++ai)
#pragma unroll
                for (int m = 0; m < 4; ++m)
#pragma unroll
                    for (int bj = 0; bj < 2; ++bj) {
                        float s = dot4(acc[ai][bj][m][0]) + dot4(acc[ai][bj][m][1]);
                        s += __shfl_xor(s, 16); s += __shfl_xor(s, 32);
                        if (fq == 0) P[((128 * ai + 16 * m + rowl0) * 2 + bj) * 4 + wc] = s;
                    }
            EPI_BAR();
            const float* gp = (isq ? qn : kn) + cl0;
            f32x4 g0 = *(const f32x4*)gp, g1 = *(const f32x4*)(gp + 4);
            if (isq) { g0 = g0 * QSCALE; g1 = g1 * QSCALE; }
            const int cp = isq ? pn : pn - 6, gi = cp >> 1;
#pragma unroll
            for (int ai = 0; ai < 2; ++ai)
#pragma unroll
                for (int m = 0; m < 4; ++m) {
                    const int rowl = 128 * ai + 16 * m + rowl0, row = u.pm * BM + rowl;
#pragma unroll
                    for (int bj = 0; bj < 2; ++bj) {
                        const f32x4 p = *(const PG8_LAS f32x4*)(P + (rowl * 2 + bj) * 4);
                        const float rinv = __builtin_amdgcn_rsqf(((p.x + p.y) + (p.z + p.w)) * (1.0f / 128.0f) + EPS);
                        const f32x4 v0 = acc[ai][bj][m][0] * rinv * g0, v1 = acc[ai][bj][m][1] * rinv * g1;
                        *(u32x4*)(Z + (size_t)row * DIN + pn * BM + bj * HALF + cl0) = pack8(v0, v1);
                        if (!isq) { float* dp = kv_dst(out, row, gi, 0, (cp & 1) * 2 + bj); if (dp) { __builtin_nontemporal_store(v0, (f32x4*)(dp + cl0)); __builtin_nontemporal_store(v1, (f32x4*)(dp + cl0 + 4)); } }
                    }
                }
        } else if (pn < 18) {
            const int cp = pn - 12, gi = cp >> 1;
#pragma unroll
            for (int ai = 0; ai < 2; ++ai)
#pragma unroll
                for (int m = 0; m < 4; ++m) {
                    const int rowl = 128 * ai + 16 * m + rowl0, row = u.pm * BM + rowl;
#pragma unroll
                    for (int bj = 0; bj < 2; ++bj) {
                        const f32x4 v0 = acc[ai][bj][m][0], v1 = acc[ai][bj][m][1];
                        *(u32x4*)(Z + (size_t)row * DIN + pn * BM + bj * HALF + cl0) = pack8(v0, v1);
                        float* dp = kv_dst(out, row, gi, 1, (cp & 1) * 2 + bj); if (dp) { __builtin_nontemporal_store(v0, (f32x4*)(dp + cl0)); __builtin_nontemporal_store(v1, (f32x4*)(dp + cl0 + 4)); }
                    }
                }
        } else {
            const bool isg = pn >= 20;
#pragma unroll
            for (int ai = 0; ai < 2; ++ai)
#pragma unroll
                for (int m = 0; m < 4; ++m) {
                    const int rowl = 128 * ai + 16 * m + rowl0, row = u.pm * BM + rowl;
                    float s = 0.f;
#pragma unroll
                    for (int bj = 0; bj < 2; ++bj) {
                        const f32x4 v0 = gelu4(acc[ai][bj][m][0]), v1 = gelu4(acc[ai][bj][m][1]);
                        s += dot4(v0) + dot4(v1);
                        *(u32x4*)(Z + (size_t)row * DIN + pn * BM + bj * HALF + cl0) = pack8(v0, v1);
                    }
                    if (isg) { s += __shfl_xor(s, 16); s += __shfl_xor(s, 32); if (fq == 0) P[rowl * 4 + wc] = s; }
                }
            if (isg) {
                EPI_BAR();
                const int t = threadIdx.x;
                if (t < 256) { const f32x4 p = *(const PG8_LAS f32x4*)(P + t * 4); ssqg[(size_t)(u.pm * BM + t) * 2 + (pn - 20)] = (p.x + p.y) + (p.z + p.w); }
            }
        }
    }
};
struct EpiX1 {
    static constexpr bool PERM = false, AFTER_DRAIN = true;
    const float* x; float* out; bf16_t* x1b; float* ssq2;
    __device__ __forceinline__ void fused(f32x4 (&acc)[2][2][4][2], const Unit& u, int wr, int wc, int fr, int fq, PG8_LAS unsigned char* xl) const {
        PG8_LAS float* P = (PG8_LAS float*)xl;
        const int rowl0 = wr * 64 + fr, col0 = u.pn * BM + wc * 32 + 4 * fq;
#pragma unroll
        for (int ai = 0; ai < 2; ++ai)
#pragma unroll
            for (int m = 0; m < 4; ++m) {
                const int rowl = 128 * ai + 16 * m + rowl0; const size_t off = (size_t)(u.pm * BM + rowl) * DM + col0;
                float s = 0.f;
#pragma unroll
                for (int bj = 0; bj < 2; ++bj)
#pragma unroll
                    for (int n = 0; n < 2; ++n) {
                        const size_t o = off + bj * HALF + n * 16;
                        const f32x4 v = __builtin_nontemporal_load((const f32x4*)(x + o)) + acc[ai][bj][m][n];
                        s += dot4(v);
                        u32x2 w; w.x = cvt_pk_bf16(v.x, v.y); w.y = cvt_pk_bf16(v.z, v.w); *(u32x2*)(x1b + o) = w;
                    }
                s += __shfl_xor(s, 16); s += __shfl_xor(s, 32);
                if (fq == 0) P[rowl * 4 + wc] = s;
            }
        EPI_BAR();
        const int t = threadIdx.x;
        if (t < 256) { const f32x4 p = *(const PG8_LAS f32x4*)(P + t * 4); ssq2[(size_t)(u.pm * BM + t) * 8 + u.pn] = (p.x + p.y) + (p.z + p.w); }
    }
};
struct EpiAct {
    static constexpr bool PERM = true, AFTER_DRAIN = false;
    bf16_t* act; const float* ssq2;
    __device__ __forceinline__ void operator()(f32x4 (&acc)[2][2][4][2], const Unit& u, int wr, int wc, int fr, int fq, PG8_LAS unsigned char*) const {
        const int rowl0 = wr * 64 + fr, cl0 = wc * 32 + 8 * fq;
#pragma unroll
        for (int ai = 0; ai < 2; ++ai)
#pragma unroll
            for (int m = 0; m < 4; ++m) {
                const int row = u.pm * BM + 128 * ai + 16 * m + rowl0;
                const f32x4 a = *(const f32x4*)(ssq2 + (size_t)row * 8), b = *(const f32x4*)(ssq2 + (size_t)row * 8 + 4);
                const float rinv = __builtin_amdgcn_rsqf((((a.x + a.y) + (a.z + a.w)) + ((b.x + b.y) + (b.z + b.w))) * (1.0f / DM) + EPS);
#pragma unroll
                for (int bj = 0; bj < 2; ++bj) {
                    f32x4 v0 = acc[ai][bj][m][0] * rinv, v1 = acc[ai][bj][m][1] * rinv;
                    v0 = __builtin_elementwise_max(v0, (f32x4){0.f, 0.f, 0.f, 0.f}); v1 = __builtin_elementwise_max(v1, (f32x4){0.f, 0.f, 0.f, 0.f});
                    *(u32x4*)(act + (size_t)row * DFF + u.pn * BM + bj * HALF + cl0) = pack8(v0 * v0, v1 * v1);
                }
            }
    }
};
struct EpiY {
    static constexpr bool PERM = false, AFTER_DRAIN = true;
    float* out; const bf16_t* x1b;
    __device__ __forceinline__ void fused(f32x4 (&acc)[2][2][4][2], const Unit& u, int wr, int wc, int fr, int fq, PG8_LAS unsigned char*) const {
        const int rowl0 = wr * 64 + fr, col0 = u.pn * BM + wc * 32 + 4 * fq;
#pragma unroll
        for (int ai = 0; ai < 2; ++ai)
#pragma unroll
            for (int m = 0; m < 4; ++m) {
                const size_t off = (size_t)(u.pm * BM + 128 * ai + 16 * m + rowl0) * DM + col0;
#pragma unroll
                for (int bj = 0; bj < 2; ++bj)
#pragma unroll
                    for (int n = 0; n < 2; ++n) { const size_t o = off + bj * HALF + n * 16; const u32x2 xb = __builtin_nontemporal_load((const u32x2*)(x1b + o));
                        *(f32x4*)(out + o) = (f32x4){bf_lo(xb.x), bf_hi(xb.x), bf_lo(xb.y), bf_hi(xb.y)} + acc[ai][bj][m][n]; }
            }
    }
};

template <class Epi, class Sched, bool ALIGN_EPI = false, bool SP2 = false>
__device__ __forceinline__ void gemm_phase(PG8_LAS unsigned char* lds, PG8_LAS unsigned char* xl, const Gemm g, const Sched& S, const Epi& E) {
    const int tid = threadIdx.x, wid = __builtin_amdgcn_readfirstlane(tid >> 6), lane = tid & 63, wr = wid >> 2, wc = wid & 3, fr = lane & 15, fq = lane >> 4;
    const int K = g.K, nt = K / BK;
    unsigned voffA[2], voffB[2];
#pragma unroll
    for (int i = 0; i < 2; ++i) { int R, C; stage_rc(tid * 16 + i * 8192, R, C); const int Rb = Epi::PERM ? ((R & ~31) + perm32(R & 31)) : R;
        voffA[i] = (unsigned)(R * K + C) * 2u; voffB[i] = (unsigned)(Rb * K + C) * 2u; }
    const size_t kstep = (size_t)(BK * 2);
    const size_t hstep = (size_t)HALF * K * 2;
    const size_t tstep = 2 * hstep;
    const unsigned ldsw = (unsigned)wid * 1024u;
    const int aoff = lds_byte(wr * 64 + fr, fq * 8), boff = lds_byte(wc * 32 + fr, fq * 8);
#define PG8_SA(b, h) (((b) * 2 + (h)) * HTB)
#define PG8_SB(b, h) ((4 + (b) * 2 + (h)) * HTB)
#define PG8_STAGE(bufoff, gbase, voff) do { _Pragma("unroll") for (int _i = 0; _i < 2; ++_i) \
        __builtin_amdgcn_global_load_lds((const unsigned*)((const char*)(gbase) + (voff)[_i]), (PG8_LAS unsigned*)(lds + (bufoff) + ldsw + _i * 8192), 16, 0, 0); } while (0)
#define PG8_LDA(dst, b, h) do { _Pragma("unroll") for (int m = 0; m < 4; ++m) _Pragma("unroll") for (int k = 0; k < 2; ++k) dst[m][k] = *(const PG8_LAS bf16x8*)(lds + PG8_SA(b, h) + aoff + m * 2048 + k * 1024); } while (0)
#define PG8_LDB(dst, b, h) do { _Pragma("unroll") for (int n = 0; n < 2; ++n) _Pragma("unroll") for (int k = 0; k < 2; ++k) dst[n][k] = *(const PG8_LAS bf16x8*)(lds + PG8_SB(b, h) + boff + n * 2048 + k * 1024); } while (0)
#define PG8_MMA(ai, bj, At, Bt) do { __builtin_amdgcn_s_setprio(1); _Pragma("unroll") for (int m = 0; m < 4; ++m) _Pragma("unroll") for (int n = 0; n < 2; ++n) _Pragma("unroll") for (int k = 0; k < 2; ++k) \
        acc[ai][bj][m][n] = __builtin_amdgcn_mfma_f32_16x16x32_bf16(Bt[n][k], At[m][k], acc[ai][bj][m][n], 0, 0, 0); __builtin_amdgcn_s_setprio(0); } while (0)
#define PG8_WAIT_V(n) asm volatile("s_waitcnt vmcnt(" #n ")" ::: "memory")
#define PG8_WAIT_L(n) asm volatile("s_waitcnt lgkmcnt(" #n ")" ::: "memory")
#define PG8_BAR __builtin_amdgcn_s_barrier()
#define PG8_SCHED __builtin_amdgcn_sched_barrier(0)
    Unit cur, nxt; int ui = 0;
    if (!S.next(0, cur)) return;
    f32x4 acc[2][2][4][2];
#pragma unroll
    for (int a = 0; a < 2; ++a)
#pragma unroll
        for (int b = 0; b < 2; ++b)
#pragma unroll
            for (int m = 0; m < 4; ++m)
#pragma unroll
                for (int n = 0; n < 2; ++n) acc[a][b][m][n] = (f32x4){0.f, 0.f, 0.f, 0.f};
    bf16x8 At[4][2], B0[2][2], B1[2][2];
    const char* cA = (const char*)g.A + (size_t)cur.pm * tstep; const char* cB = (const char*)g.Bt + (size_t)cur.pn * tstep;
    S.a_ready(cur);
    if constexpr (SP2) {
        PG8_STAGE(PG8_SB(0, 0), cB, voffB); PG8_STAGE(PG8_SB(0, 1), cB + hstep, voffB); PG8_STAGE(PG8_SA(0, 0), cA, voffA); PG8_STAGE(PG8_SA(0, 1), cA + hstep, voffA);
        if (wr == 1) PG8_BAR;
        PG8_WAIT_V(2); PG8_BAR;
        PG8_STAGE(PG8_SB(1, 0), cB + kstep, voffB); PG8_STAGE(PG8_SA(1, 0), cA + kstep, voffA); PG8_STAGE(PG8_SB(1, 1), cB + hstep + kstep, voffB);
        PG8_WAIT_V(6); PG8_BAR;
    } else {
        PG8_STAGE(PG8_SB(0, 0), cB, voffB); PG8_STAGE(PG8_SA(0, 0), cA, voffA); PG8_STAGE(PG8_SB(0, 1), cB + hstep, voffB); PG8_STAGE(PG8_SA(0, 1), cA + hstep, voffA);
        if (wr == 1) PG8_BAR;
        PG8_WAIT_V(4); PG8_BAR;
        PG8_STAGE(PG8_SB(1, 0), cB + kstep, voffB); PG8_STAGE(PG8_SA(1, 0), cA + kstep, voffA); PG8_STAGE(PG8_SB(1, 1), cB + hstep + kstep, voffB);
        PG8_WAIT_V(6); PG8_BAR;
    }
    for (;;) {
        const bool has_next = S.next(ui + 1, nxt);
        const char* nA = has_next ? (const char*)g.A + (size_t)nxt.pm * tstep : cA; const char* nB = has_next ? (const char*)g.Bt + (size_t)nxt.pn * tstep : cB;
        for (int t = 0; t < nt; t += 2) {
            const bool last = (t == nt - 2);
            const char* a1 = cA + (size_t)(t + 1) * kstep;
            const char* a2 = last ? nA : cA + (size_t)(t + 2) * kstep; const char* b2 = last ? nB : cB + (size_t)(t + 2) * kstep;
            const char* a3 = a2 + kstep; const char* b3 = b2 + kstep;
            if (last && has_next) S.a_ready(nxt);
            if constexpr (SP2) {
            PG8_LDB(B0, 0, 0); PG8_LDB(B1, 0, 1); PG8_SCHED; PG8_LDA(At, 0, 0); PG8_STAGE(PG8_SA(1, 1), a1 + hstep, voffA);
            PG8_WAIT_V(8); PG8_WAIT_L(0); PG8_BAR; PG8_MMA(0, 0, At, B0); PG8_MMA(0, 1, At, B1); PG8_BAR; PG8_SCHED;
            PG8_LDA(At, 0, 1); PG8_STAGE(PG8_SB(0, 0), b2, voffB); PG8_STAGE(PG8_SB(0, 1), b2 + hstep, voffB); PG8_STAGE(PG8_SA(0, 0), a2, voffA);
            PG8_WAIT_V(8); PG8_WAIT_L(0); PG8_BAR; PG8_MMA(1, 0, At, B0); PG8_MMA(1, 1, At, B1); PG8_BAR; PG8_SCHED;
            PG8_LDB(B0, 1, 0); PG8_LDB(B1, 1, 1); PG8_SCHED; PG8_LDA(At, 1, 0); PG8_STAGE(PG8_SA(0, 1), a2 + hstep, voffA);
            PG8_WAIT_V(8); PG8_WAIT_L(0); PG8_BAR; PG8_MMA(0, 0, At, B0); PG8_MMA(0, 1, At, B1); PG8_BAR; PG8_SCHED;
            PG8_LDA(At, 1, 1); PG8_STAGE(PG8_SB(1, 0), b3, voffB); PG8_STAGE(PG8_SB(1, 1), b3 + hstep, voffB); PG8_STAGE(PG8_SA(1, 0), a3, voffA);
            PG8_WAIT_V(8); PG8_WAIT_L(0); PG8_BAR; PG8_MMA(1, 0, At, B0); PG8_MMA(1, 1, At, B1); PG8_BAR; PG8_SCHED;
            } else {
            PG8_LDB(B0, 0, 0); PG8_SCHED; PG8_LDA(At, 0, 0); PG8_STAGE(PG8_SA(1, 1), a1 + hstep, voffA);
            PG8_WAIT_L(8); PG8_BAR; PG8_WAIT_L(0); PG8_MMA(0, 0, At, B0); PG8_BAR; PG8_SCHED;
            PG8_LDB(B1, 0, 1); PG8_STAGE(PG8_SB(0, 0), b2, voffB);
            PG8_BAR; PG8_WAIT_L(0); PG8_MMA(0, 1, At, B1); PG8_BAR;
            PG8_LDA(At, 0, 1); PG8_STAGE(PG8_SA(0, 0), a2, voffA);
            PG8_BAR; PG8_WAIT_L(0); PG8_MMA(1, 0, At, B0); PG8_BAR; PG8_SCHED;
            PG8_STAGE(PG8_SB(0, 1), b2 + hstep, voffB);
            PG8_WAIT_V(6); PG8_BAR; PG8_MMA(1, 1, At, B1); PG8_BAR;
            PG8_LDB(B0, 1, 0); PG8_SCHED; PG8_LDA(At, 1, 0); PG8_STAGE(PG8_SA(0, 1), a2 + hstep, voffA);
            PG8_WAIT_L(8); PG8_BAR; PG8_WAIT_L(0); PG8_MMA(0, 0, At, B0); PG8_BAR; PG8_SCHED;
            PG8_LDB(B1, 1, 1); PG8_STAGE(PG8_SB(1, 0), b3, voffB);
            PG8_BAR; PG8_WAIT_L(0); PG8_MMA(0, 1, At, B1); PG8_BAR;
            PG8_LDA(At, 1, 1); PG8_STAGE(PG8_SA(1, 0), a3, voffA);
            PG8_BAR; PG8_WAIT_L(0); PG8_MMA(1, 0, At, B0); PG8_BAR; PG8_SCHED;
            PG8_STAGE(PG8_SB(1, 1), b3 + hstep, voffB);
            PG8_WAIT_V(6); PG8_BAR; PG8_MMA(1, 1, At, B1); PG8_BAR;
            }
        }
        if constexpr (ALIGN_EPI) { if (wr == 0) PG8_BAR; }
        if constexpr (!Epi::AFTER_DRAIN) { E(acc, cur, wr, wc, fr, fq, xl); S.done(cur); }
        if (!has_next) break;
#pragma unroll
        for (int a = 0; a < 2; ++a)
#pragma unroll
            for (int b = 0; b < 2; ++b)
#pragma unroll
                for (int m = 0; m < 4; ++m)
#pragma unroll
                    for (int n = 0; n < 2; ++n) acc[a][b][m][n] = (f32x4){0.f, 0.f, 0.f, 0.f};
        cur = nxt; cA = nA; cB = nB; ++ui;
        if constexpr (ALIGN_EPI) { if (wr == 1) PG8_BAR; }
    }
    PG8_WAIT_V(0);
    if constexpr (!ALIGN_EPI) { if (wr == 0) PG8_BAR; }
    PG8_BAR;
    if constexpr (Epi::AFTER_DRAIN) { E.fused(acc, cur, wr, wc, fr, fq, xl); S.done(cur); }
#undef PG8_SA
#undef PG8_SB
#undef PG8_STAGE
#undef PG8_LDA
#undef PG8_LDB
#undef PG8_MMA
#undef PG8_WAIT_V
#undef PG8_WAIT_L
#undef PG8_BAR
#undef PG8_SCHED
}
}

typedef GAS unsigned gu32;
#define RLX_AGENT __ATOMIC_RELAXED, __HIP_MEMORY_SCOPE_AGENT
#define XB_TMO      128
#define XB_XCNT(j)  (256  + 64 * (j))
#define XB_XSUB(j)  (1280 + 64 * (j))
#define XB_XGEN(j)  (2304 + 64 * (j))
#define XB_TOP      3328
#define XB_TOPGEN   3392
#define XCD_BAR_WORDS 3456
#define XB_SPIN_CAP (1u << 18)
__device__ __forceinline__ unsigned xb_ld(unsigned* p)              { return __hip_atomic_load(p, __ATOMIC_RELAXED, __HIP_MEMORY_SCOPE_AGENT); }
__device__ __forceinline__ unsigned xb_add(unsigned* p, unsigned v) { return __hip_atomic_fetch_add(p, v, __ATOMIC_RELAXED, __HIP_MEMORY_SCOPE_AGENT); }
__device__ __forceinline__ unsigned xb_xcc_id() { return (unsigned)__builtin_amdgcn_s_getreg((3 << 11) | 20) & 0xFu; }
#define XB_SPIN(cond, bar) do { unsigned _sp = 0; while (cond) { __builtin_amdgcn_s_sleep(1); \
    if ((++_sp & 255u) == 0u) { if (xb_ld(&(bar)[XB_TMO])) break; if (_sp > XB_SPIN_CAP) { atomicAdd(&(bar)[XB_TMO], 1u); break; } } } } while (0)
struct XcdBarrier { unsigned* bar; unsigned x; volatile LAS unsigned* st; };
__device__ __forceinline__ XcdBarrier xcd_barrier_post(unsigned* bar, volatile LAS unsigned* st) {
    XcdBarrier b; b.bar = bar; b.x = xb_xcc_id(); b.st = st;
    if (threadIdx.x == 0) (void)xb_add(&bar[XB_XCNT(b.x)], 1u);
    return b;
}
__device__ __forceinline__ void xcd_barrier_complete(unsigned* bar, unsigned x, unsigned& nloc, unsigned& nx) {
    const unsigned G = gridDim.x * gridDim.y * gridDim.z;
    unsigned sum, cnt, mine, sp = 0u;
    for (;;) {
        sum = 0u; cnt = 0u; mine = 0u;
#pragma unroll
        for (unsigned j = 0; j < 16; ++j) { const unsigned c = xb_ld(&bar[XB_XCNT(j)]); sum += c; cnt += (c > 0u) ? 1u : 0u; mine = (j == x) ? c : mine; }
        if (sum == G) break;
        __builtin_amdgcn_s_sleep(1);
        if ((++sp & 255u) == 0u) { if (xb_ld(&bar[XB_TMO])) break; if (sp > XB_SPIN_CAP) { atomicAdd(&bar[XB_TMO], 1u); break; } }
    }
    nloc = mine > 0u ? mine : 1u; nx = cnt > 0u ? cnt : 1u;
}
__device__ __forceinline__ void xcd_barrier(const XcdBarrier& b) {
    asm volatile("s_waitcnt vmcnt(0)" ::: "memory");
    __syncthreads();
    if (threadIdx.x == 0) {
        unsigned* bar = b.bar;
        __builtin_amdgcn_s_waitcnt(0);
        unsigned nloc = b.st[0], nx = b.st[1];
        if (nloc == 0u) { xcd_barrier_complete(bar, b.x, nloc, nx); b.st[0] = nloc; b.st[1] = nx; }
        const unsigned old = xb_add(&bar[XB_XSUB(b.x)], 1u);
        const unsigned gen = old / nloc;
        if (old + 1u == (gen + 1u) * nloc) {
            __builtin_amdgcn_fence(__ATOMIC_RELEASE, "agent");
            asm volatile("s_waitcnt vmcnt(0)" ::: "memory");
            const unsigned og = xb_add(&bar[XB_TOP], 1u);
            const unsigned tg = og / nx;
            if (og + 1u == (tg + 1u) * nx) xb_add(&bar[XB_TOPGEN], 1u);
            else XB_SPIN(xb_ld(&bar[XB_TOPGEN]) == tg, bar);
            __builtin_amdgcn_fence(__ATOMIC_ACQUIRE, "agent");
            xb_add(&bar[XB_XGEN(b.x)], 1u);
            asm volatile("s_waitcnt vmcnt(0)" ::: "memory");
        } else {
            XB_SPIN(xb_ld(&bar[XB_XGEN(b.x)]) == gen, bar);
            __builtin_amdgcn_fence(__ATOMIC_ACQUIRE, "agent");
            asm volatile("s_waitcnt vmcnt(0)" ::: "memory");
        }
    }
    __syncthreads();
}

#define LDS_WAIT() asm volatile("s_waitcnt lgkmcnt(0)" ::: "memory")
__device__ __forceinline__ int t5_bucket(int dist) {
    if (dist < 16) return dist;
    const float v = log2f((float)dist * (1.0f / 16.0f)) * (16.0f / 7.0f);
    const int b = 16 + (int)v;
    return b > 31 ? 31 : b;
}
typedef short v4i16_t __attribute__((ext_vector_type(4)));
__device__ __forceinline__ s16x4 tr4(const LAS unsigned char* p) { return __builtin_bit_cast(s16x4, __builtin_amdgcn_ds_read_tr16_b64_v4i16((LAS v4i16_t*)p)); }
__device__ __forceinline__ int kswz(int j) { return ((j >> 1) & 12) | (j & 3); }
__device__ __forceinline__ int vswz(int j) { return (j & 3) | (((j >> 3) & 1) << 2); }

struct P0Item { const float* W; bf16_t* WT; const float* sc; int K, N, k0, n0; };
__device__ __forceinline__ void p0_load(const P0Item& q, f32x4 (&w)[8], int lane) {
    const float* p = q.W + (size_t)(q.k0 + (lane >> 3)) * q.N + q.n0 + 4 * (lane & 7);
#pragma unroll
    for (int i = 0; i < 8; ++i) w[i] = __builtin_nontemporal_load((const f32x4*)(p + (size_t)(8 * i) * q.N));
}
__device__ __forceinline__ void p0_to_lds(const P0Item& q, const f32x4 (&w)[8], LAS float* scr, int lane) {
#pragma unroll
    for (int i = 0; i < 8; ++i) { const int kk = 8 * i + (lane >> 3); f32x4 v = w[i]; if (q.sc) v = v * q.sc[q.k0 + kk];
        LAS float* d = scr + kk * 33 + 4 * (lane & 7); d[0] = v.x; d[1] = v.y; d[2] = v.z; d[3] = v.w; }
    LDS_WAIT(); asm volatile("" ::: "memory");
}
__device__ __forceinline__ void p0_from_lds(const P0Item& q, LAS float* scr, int lane) {
    const int c = lane & 7;
#pragma unroll
    for (int j = 0; j < 4; ++j) { const int n = (lane >> 3) + 8 * j; const LAS float* s = scr + (8 * c) * 33 + n;
        u32x4 o; o.x = cvt_pk_bf16(s[0 * 33], s[1 * 33]); o.y = cvt_pk_bf16(s[2 * 33], s[3 * 33]); o.z = cvt_pk_bf16(s[4 * 33], s[5 * 33]); o.w = cvt_pk_bf16(s[6 * 33], s[7 * 33]);
        *(u32x4*)(q.WT + (size_t)(q.n0 + n) * q.K + q.k0 + 8 * c) = o; }
    LDS_WAIT(); asm volatile("" ::: "memory");
}

constexpr int P0_I_IN = (DM / 64) * (DIN / 32), P0_I_OUT = (DMIX / 64) * (DM / 32), P0_I_UP = (DM / 64) * (DFF / 32), P0_I_DN = (DFF / 64) * (DM / 32);
constexpr int P0_NITEMS = P0_I_IN + P0_I_OUT + P0_I_UP + P0_I_DN;
struct P0Weights { const float *w_in, *w_out, *w_up, *w_down, *norm_ffn; bf16_t *WinT, *WoutT, *WupT, *WdnT; };
__device__ __forceinline__ P0Item p0_sel(const P0Weights& w, int it) {
    P0Item q; int r = it;
    if (r < P0_I_IN) { q.W = w.w_in; q.WT = w.WinT; q.sc = nullptr; q.K = DM; q.N = DIN; }
    else if ((r -= P0_I_IN) < P0_I_OUT) { q.W = w.w_out; q.WT = w.WoutT; q.sc = nullptr; q.K = DMIX; q.N = DM; }
    else if ((r -= P0_I_OUT) < P0_I_UP) { q.W = w.w_up; q.WT = w.WupT; q.sc = w.norm_ffn; q.K = DM; q.N = DFF; }
    else { r -= P0_I_UP; q.W = w.w_down; q.WT = w.WdnT; q.sc = nullptr; q.K = DFF; q.N = DM; }
    const int nblk = q.N / 32; q.k0 = 64 * (r / nblk); q.n0 = 32 * (r % nblk); return q;
}
struct Args {
    const float* in[17]; float* out; unsigned char* ws; int ph_lo, ph_hi, li, pad;
};

struct AttnDesc { int g, b, hh, r, blk, dil; const bf16_t* Zb; size_t kstride; };
__device__ __forceinline__ AttnDesc attn_decode(const bf16_t* Z, int item) {
    AttnDesc d; d.g = item >> 8; const int rem = item & 255; d.b = rem >> 7; d.hh = (rem >> 5) & 3; const int rb = rem & 31, sh = 2 * d.g;
    d.dil = 1 << sh; d.r = rb >> (5 - sh); d.blk = rb & ((32 >> sh) - 1);
    d.kstride = (size_t)d.dil * DIN;
    d.Zb = Z + (size_t)(d.b * SEQ + d.r) * DIN + d.g * 512 + d.hh * 128;
    return d;
}
__device__ __forceinline__ void attn_load(const AttnDesc& d, u32x4 (&kreg)[8], u32x4 (&vreg)[8], bf16x8 (&qf)[4], int tid, int lane, int wid) {
    const int n = lane & 15, fq = lane >> 4, iq = 16 * wid + n;
    const bf16_t* qsrc = d.Zb + (size_t)(128 * d.blk + iq) * d.kstride + 8 * fq;
#pragma unroll
    for (int ks = 0; ks < 4; ++ks) qf[ks] = *(const bf16x8*)(qsrc + 32 * ks);
    const int j0 = tid >> 4, c = tid & 15;
    const bf16_t* src0 = d.Zb + (size_t)((long)(128 * (d.blk - 1) + j0)) * d.kstride + c * 8;
    const size_t istep = 32 * d.kstride;
#pragma unroll
    for (int i = 0; i < 8; ++i) {
        if (d.blk > 0 || i >= 4) { const bf16_t* src = src0 + i * istep; kreg[i] = *(const u32x4*)(src + ZK); vreg[i] = *(const u32x4*)(src + ZV); }
        else { kreg[i] = (u32x4){0u, 0u, 0u, 0u}; vreg[i] = kreg[i]; }
    }
}
__device__ __forceinline__ void attn_stage(const AttnDesc& d, const u32x4 (&kreg)[8], const u32x4 (&vreg)[8], LAS unsigned char* lds, LAS unsigned char* xl, const float* relb, int tid) {
    LAS unsigned char* Kl = lds; LAS unsigned char* Vl = lds + 65536; LAS float* bl = (LAS float*)xl;
    const int j0 = tid >> 4, c = tid & 15;
    LAS unsigned char* kd = Kl + j0 * 256 + ((c ^ kswz(j0)) << 4);
    LAS unsigned char* vd = Vl + j0 * 256 + ((((c >> 1) ^ vswz(j0)) << 5) | ((c & 1) << 4));
#pragma unroll
    for (int i = 0; i < 8; ++i) { *(LAS u32x4*)(kd + i * 8192) = kreg[i]; *(LAS u32x4*)(vd + i * 8192) = vreg[i]; }
    if (tid < 192) { const int dist = tid - 32; bl[tid] = (dist >= 0 && dist <= 128) ? relb[t5_bucket(dist * d.dil) * 12 + d.g * 4 + d.hh] * LOG2E : -INFINITY; }
}
__device__ __forceinline__ void attn_compute(const AttnDesc& d, const bf16x8 (&qf)[4], LAS unsigned char* lds, LAS unsigned char* xl, bf16_t* OG, float* LSE, int lane, int wid) {
    const LAS unsigned char* Kl = lds; const LAS unsigned char* Vl = lds + 65536; const LAS float* bl = (const LAS float*)xl;
    const int n = lane & 15, fq = lane >> 4, iq = 16 * wid + n, blk = d.blk;
    const int G0 = wid >> 1;
    f32x4 sc[5][2];
#pragma unroll
    for (int gi = 0; gi < 5; ++gi) {
        const int G = G0 + gi;
        sc[gi][0] = (f32x4){0.f, 0.f, 0.f, 0.f}; sc[gi][1] = sc[gi][0];
        if (blk == 0 && G < 4) { sc[gi][0] = (f32x4){-INFINITY, -INFINITY, -INFINITY, -INFINITY}; sc[gi][1] = sc[gi][0]; }
        else {
#pragma unroll
            for (int bb = 0; bb < 2; ++bb) {
                const LAS unsigned char* kp = Kl + (32 * G + 8 * (n >> 2) + 4 * bb + (n & 3)) * 256;
#pragma unroll
                for (int ks = 0; ks < 4; ++ks) {
                    const bf16x8 kf = *(const LAS bf16x8*)(kp + (((4 * ks + fq) ^ n) << 4));
                    sc[gi][bb] = __builtin_amdgcn_mfma_f32_16x16x32_bf16(kf, qf[ks], sc[gi][bb], 0, 0, 0);
                }
            }
        }
        __builtin_amdgcn_sched_barrier(0);
    }
    float mx = -INFINITY;
    const LAS float* blp = bl + (iq + 128 + 32 - 32 * G0 - 8 * fq);
#pragma unroll
    for (int gi = 0; gi < 5; ++gi)
#pragma unroll
        for (int bb = 0; bb < 2; ++bb)
#pragma unroll
            for (int e = 0; e < 4; ++e) {
                const float s = sc[gi][bb][e] + blp[-(32 * gi + 4 * bb + e)];
                sc[gi][bb][e] = s; mx = fmaxf(mx, s);
            }
    mx = fmaxf(mx, __shfl_xor(mx, 16)); mx = fmaxf(mx, __shfl_xor(mx, 32));
    float l = 0.f;
    bf16x8 pf[5];
#pragma unroll
    for (int gi = 0; gi < 5; ++gi) {
        float p[8];
#pragma unroll
        for (int bb = 0; bb < 2; ++bb)
#pragma unroll
            for (int e = 0; e < 4; ++e) { p[4 * bb + e] = __builtin_amdgcn_exp2f(sc[gi][bb][e] - mx); l += p[4 * bb + e]; }
        u32x4 w; w.x = cvt_pk_bf16(p[0], p[1]); w.y = cvt_pk_bf16(p[2], p[3]); w.z = cvt_pk_bf16(p[4], p[5]); w.w = cvt_pk_bf16(p[6], p[7]);
        pf[gi] = __builtin_bit_cast(bf16x8, w);
    }
    l += __shfl_xor(l, 16); l += __shfl_xor(l, 32);
    f32x4 oacc[8];
#pragma unroll
    for (int db = 0; db < 8; ++db) oacc[db] = (f32x4){0.f, 0.f, 0.f, 0.f};
    const int sv = (n >> 2) | ((fq & 1) << 2);
#pragma unroll
    for (int gi = 0; gi < 5; ++gi) {
        const int G = G0 + gi;
        if (blk > 0 || G >= 4) {
            const LAS unsigned char* vp = Vl + (32 * G + 8 * fq + (n >> 2)) * 256 + 8 * (n & 3);
#pragma unroll
            for (int db = 0; db < 8; ++db) {
                const LAS unsigned char* a = vp + ((db ^ sv) << 5);
                const s16x4 lo = tr4(a), hi = tr4(a + 1024);
                const bf16x8 vf = (bf16x8){lo[0], lo[1], lo[2], lo[3], hi[0], hi[1], hi[2], hi[3]};
                oacc[db] = __builtin_amdgcn_mfma_f32_16x16x32_bf16(vf, pf[gi], oacc[db], 0, 0, 0);
            }
        }
        __builtin_amdgcn_sched_barrier(0);
    }
    const float inv = 1.0f / l;
    const size_t row = (size_t)(d.b * SEQ + d.r) + (size_t)d.dil * (128 * blk + iq);
    bf16_t* op = OG + ((size_t)d.g * MPAD + row) * 512 + d.hh * 128 + 4 * fq;
#pragma unroll
    for (int db = 0; db < 8; ++db) { u32x2 w; w.x = cvt_pk_bf16(oacc[db].x * inv, oacc[db].y * inv); w.y = cvt_pk_bf16(oacc[db].z * inv, oacc[db].w * inv); *(u32x2*)(op + 16 * db) = w; }
    if (fq == 0) LSE[((size_t)d.g * MPAD + row) * 4 + d.hh] = mx + log2f(l);
}

__device__ __forceinline__ void gate_load(const bf16_t* Z, int item, u32x4 (&greg)[4], int tid) {
    const int b = item >> 7, nc = (item >> 2) & 31, g = item & 3, row0 = b * SEQ + 128 * nc;
    const bf16_t* src0 = Z + (size_t)(row0 + (tid >> 4)) * DIN + ZG + g * 128 + (tid & 15) * 8;
#pragma unroll
    for (int i = 0; i < 4; ++i) greg[i] = *(const u32x4*)(src0 + (size_t)i * 32 * DIN);
}
__device__ __forceinline__ void gate_stage(int item, const u32x4 (&greg)[4], LAS unsigned char* lds, LAS unsigned char* xl, const float* ssqg, int tid) {
    const int b = item >> 7, nc = (item >> 2) & 31, row0 = b * SEQ + 128 * nc;
    LAS unsigned char* Gl = lds; LAS float* rl = (LAS float*)xl;
    const int j0 = tid >> 4, c = tid & 15;
    LAS unsigned char* gd = Gl + j0 * 256 + ((((c >> 1) ^ vswz(j0)) << 5) | ((c & 1) << 4));
#pragma unroll
    for (int i = 0; i < 4; ++i) *(LAS u32x4*)(gd + i * 8192) = greg[i];
    if (tid < 128) rl[tid] = __builtin_amdgcn_rsqf((ssqg[(size_t)(row0 + tid) * 2] + ssqg[(size_t)(row0 + tid) * 2 + 1]) * (1.0f / 512.0f) + EPS);
}
__device__ __forceinline__ void gate_compute(int item, LAS unsigned char* lds, LAS unsigned char* xl, const bf16_t* Z, const float* gw, const float* gb, const float* vn, bf16_t* MIX, int lane, int wid) {
    const int b = item >> 7, nc = (item >> 2) & 31, g = item & 3, row0 = b * SEQ + 128 * nc;
    const LAS unsigned char* Gl = lds; const LAS float* rl = (const LAS float*)xl;
    const int n = lane & 15, fq = lane >> 4, t = 16 * wid + n;
    f32x4 acc[8];
#pragma unroll
    for (int cb = 0; cb < 8; ++cb) acc[cb] = (f32x4){0.f, 0.f, 0.f, 0.f};
    const int sv = (n >> 2) | ((fq & 1) << 2);
#pragma unroll
    for (int ks = 0; ks < 4; ++ks) {
        if (ks <= (wid >> 1)) {
            const int s0 = 32 * ks + 8 * fq;
            const float* wp = gw + ((size_t)g * 128 + t) * 128 + s0;
            const f32x4 w0 = *(const f32x4*)wp, w1 = *(const f32x4*)(wp + 4);
            const f32x4 r0 = *(const LAS f32x4*)(rl + s0), r1 = *(const LAS f32x4*)(rl + s0 + 4);
            float wv[8] = {w0.x * r0.x, w0.y * r0.y, w0.z * r0.z, w0.w * r0.w, w1.x * r1.x, w1.y * r1.y, w1.z * r1.z, w1.w * r1.w};
#pragma unroll
            for (int e = 0; e < 8; ++e) wv[e] = (s0 + e <= t) ? wv[e] : 0.f;
            u32x4 w; w.x = cvt_pk_bf16(wv[0], wv[1]); w.y = cvt_pk_bf16(wv[2], wv[3]); w.z = cvt_pk_bf16(wv[4], wv[5]); w.w = cvt_pk_bf16(wv[6], wv[7]);
            const bf16x8 wf = __builtin_bit_cast(bf16x8, w);
            const LAS unsigned char* vp = Gl + (32 * ks + 8 * fq + (n >> 2)) * 256 + 8 * (n & 3);
#pragma unroll
            for (int cb = 0; cb < 8; ++cb) {
                const LAS unsigned char* a = vp + ((cb ^ sv) << 5);
                const s16x4 lo = tr4(a), hi = tr4(a + 1024);
                const bf16x8 gf = (bf16x8){lo[0], lo[1], lo[2], lo[3], hi[0], hi[1], hi[2], hi[3]};
                acc[cb] = __builtin_amdgcn_mfma_f32_16x16x32_bf16(gf, wf, acc[cb], 0, 0, 0);
            }
        }
    }
    const float bt = gb[g * 128 + t];
    const bf16_t* up = Z + (size_t)(row0 + t) * DIN + ZU + g * 128 + 4 * fq;
    bf16_t* mp = MIX + (size_t)(row0 + t) * DMIX + 512 + g * 128 + 4 * fq;
#pragma unroll
    for (int cb = 0; cb < 8; ++cb) {
        const f32x4 gn = *(const f32x4*)(vn + g * 128 + 16 * cb + 4 * fq);
        const u32x2 uu = *(const u32x2*)(up + 16 * cb);
        const f32x4 mixed = acc[cb] * gn + bt;
        u32x2 w; w.x = cvt_pk_bf16(bf_lo(uu.x) * mixed.x, bf_hi(uu.x) * mixed.y); w.y = cvt_pk_bf16(bf_lo(uu.y) * mixed.z, bf_hi(uu.y) * mixed.w);
        *(u32x2*)(mp + 16 * cb) = w;
    }
}

__device__ __forceinline__ void sattn_item(LAS unsigned char* xl, const bf16_t* Z, const float* cache, const float* relb, bf16_t* OG, float* LSE, int g, int rem, int tid, int lane, int wid) {
    const int db = rem >> 4, hh = (rem >> 2) & 3, t = rem & 3;
    const int sh = 2 * g, dil = 1 << sh, L = 128 << sh;
    LAS float* bl = (LAS float*)(xl + 6144);
    LAS float* red = (LAS float*)(xl + 1024);
    LAS float* ml = (LAS float*)(xl + 1024 + 4096);
    if (tid < 129) bl[tid] = relb[t5_bucket(tid * dil) * 12 + g * 4 + hh] * LOG2E;
    const int qrow = MP + db * 4 + t;
    const unsigned qq = *(const unsigned*)(Z + (size_t)qrow * DIN + g * 512 + hh * 128 + 2 * lane);
    const size_t hoff = (size_t)hh * 128 + 2 * lane;
    float k0[17], k1[17], v0[17], v1[17];
#pragma unroll
    for (int k = 0; k < 17; ++k) {
        const int s = wid + 8 * k; k0[k] = 0.f; k1[k] = 0.f; v0[k] = 0.f; v1[k] = 0.f;
        if (s <= 128) {
            const int idx = L + t - s * dil;
            if (idx >= L) { const bf16_t* zp = Z + (size_t)(MP + db * 4 + (idx - L)) * DIN + g * 512 + hoff; const unsigned kk = *(const unsigned*)(zp + ZK), vv = *(const unsigned*)(zp + ZV);
                k0[k] = bf_lo(kk); k1[k] = bf_hi(kk); v0[k] = bf_lo(vv); v1[k] = bf_hi(vv); }
            else { const float* cp = cache + ((size_t)(db * 2 + 0) * L + idx) * 512 + hoff; const f32x2 kk = __builtin_nontemporal_load((const f32x2*)cp), vv = __builtin_nontemporal_load((const f32x2*)(cp + (size_t)L * 512));
                k0[k] = kk.x; k1[k] = kk.y; v0[k] = vv.x; v1[k] = vv.y; }
        }
    }
    const float q0 = bf_lo(qq), q1 = bf_hi(qq);
    __syncthreads();
    float mys = -INFINITY;
#pragma unroll
    for (int k = 0; k < 17; ++k) {
        const int s = wid + 8 * k;
        const float dd = wave_sum(q0 * k0[k] + q1 * k1[k]);
        if (s <= 128 && lane == k) mys = dd + bl[s <= 128 ? s : 0];
    }
    const float mw = wave_max(mys);
    const float p = __builtin_amdgcn_exp2f(mys - mw);
    const float lw = wave_sum(p);
    float o0 = 0.f, o1 = 0.f;
#pragma unroll
    for (int k = 0; k < 17; ++k) { const float pk = __shfl(p, k); o0 += pk * v0[k]; o1 += pk * v1[k]; }
    red[wid * 128 + 2 * lane] = o0; red[wid * 128 + 2 * lane + 1] = o1;
    if (lane == 0) { ml[wid] = mw; ml[8 + wid] = lw; }
    __syncthreads();
    if (tid < 128) {
        float M = ml[0];
#pragma unroll
        for (int w = 1; w < 8; ++w) M = fmaxf(M, ml[w]);
        float Ls = 0.f, o = 0.f;
#pragma unroll
        for (int w = 0; w < 8; ++w) { const float f = __builtin_amdgcn_exp2f(ml[w] - M); Ls += ml[8 + w] * f; o += red[w * 128 + tid] * f; }
        o = o / Ls;
        const float on = __shfl_down(o, 1);
        if ((tid & 1) == 0) *(unsigned*)(OG + ((size_t)g * MPAD + qrow) * 512 + hh * 128 + tid) = cvt_pk_bf16(o, on);
        if (tid == 0) LSE[((size_t)g * MPAD + qrow) * 4 + hh] = M + log2f(Ls);
    }
    __syncthreads();
}

__device__ __forceinline__ void sgate_item(const bf16_t* Z, const float* ssqg, const float* gw, const float* gb, const float* vn, bf16_t* MIX, float* out, int tid) {
    const int db = tid >> 6, c0 = 8 * (tid & 63), grp = c0 >> 7;
    const f32x4 ga = *(const f32x4*)(vn + c0), gb4 = *(const f32x4*)(vn + c0 + 4);
    const float gain[8] = {ga.x, ga.y, ga.z, ga.w, gb4.x, gb4.y, gb4.z, gb4.w};
    float gn[4][8];
#pragma unroll
    for (int s = 0; s < 4; ++s) {
        const int row = MP + db * 4 + s;
        const float rinv = __builtin_amdgcn_rsqf((ssqg[(size_t)row * 2] + ssqg[(size_t)row * 2 + 1]) * (1.0f / 512.0f) + EPS);
        const u32x4 gg = *(const u32x4*)(Z + (size_t)row * DIN + ZG + c0);
#pragma unroll
        for (int j = 0; j < 4; ++j) { gn[s][2 * j] = bf_lo(gg[j]) * rinv * gain[2 * j]; gn[s][2 * j + 1] = bf_hi(gg[j]) * rinv * gain[2 * j + 1]; }
        float* op = out + OUT_GV + (size_t)(db * 4 + s) * 512 + c0;
        *(f32x4*)op = (f32x4){gn[s][0], gn[s][1], gn[s][2], gn[s][3]}; *(f32x4*)(op + 4) = (f32x4){gn[s][4], gn[s][5], gn[s][6], gn[s][7]};
    }
#pragma unroll
    for (int t = 0; t < 4; ++t) {
        const int row = MP + db * 4 + t;
        const u32x4 uu = *(const u32x4*)(Z + (size_t)row * DIN + ZU + c0);
        const float bt = gb[grp * 128 + t];
        float mixed[8];
#pragma unroll
        for (int e = 0; e < 8; ++e) mixed[e] = bt;
#pragma unroll
        for (int s = 0; s < 4; ++s) if (s <= t) { const float w = gw[((size_t)grp * 128 + t) * 128 + s];
#pragma unroll
            for (int e = 0; e < 8; ++e) mixed[e] += w * gn[s][e]; }
        u32x4 w;
#pragma unroll
        for (int j = 0; j < 4; ++j) w[j] = cvt_pk_bf16(bf_lo(uu[j]) * mixed[2 * j], bf_hi(uu[j]) * mixed[2 * j + 1]);
        *(u32x4*)(MIX + (size_t)row * DMIX + 512 + c0) = w;
    }
}

template <class F>
__device__ __forceinline__ void skinny_gemm(LAS unsigned char* lds, const bf16_t* A, const bf16_t* Bt, int K, int N, int KP, int vcu, int G, int tid, int lane, int wid, const F& f) {
    LAS float* red = (LAS float*)lds;
    const int n = lane & 15, fq = lane >> 4, nblk = N / 32, nitems = nblk * KP, kpart = K / KP, kw = kpart / 8;
    for (int it = vcu; it < nitems; it += G) {
        const int ib = it % nblk, kp = it / nblk, n0 = 32 * ib, kb = kp * kpart + wid * kw;
        f32x4 a00 = (f32x4){0.f, 0.f, 0.f, 0.f}, a01 = a00, a10 = a00, a11 = a00;
        const bf16_t* wp = Bt + (size_t)(n0 + n) * K + kb + 8 * fq;
        const bf16_t* ap = A + (size_t)n * K + kb + 8 * fq;
#pragma unroll 4
        for (int k = 0; k < kw; k += 32) {
            const bf16x8 w0 = *(const bf16x8*)(wp + k), w1 = *(const bf16x8*)(wp + (size_t)16 * K + k), x0 = *(const bf16x8*)(ap + k), x1 = *(const bf16x8*)(ap + (size_t)16 * K + k);
            a00 = __builtin_amdgcn_mfma_f32_16x16x32_bf16(w0, x0, a00, 0, 0, 0);
            a01 = __builtin_amdgcn_mfma_f32_16x16x32_bf16(w0, x1, a01, 0, 0, 0);
            a10 = __builtin_amdgcn_mfma_f32_16x16x32_bf16(w1, x0, a10, 0, 0, 0);
            a11 = __builtin_amdgcn_mfma_f32_16x16x32_bf16(w1, x1, a11, 0, 0, 0);
        }
        *(LAS f32x4*)(red + (((wid * 2 + 0) * 2 + 0) * 16 + n) * 16 + 4 * fq) = a00;
        *(LAS f32x4*)(red + (((wid * 2 + 0) * 2 + 1) * 16 + n) * 16 + 4 * fq) = a01;
        *(LAS f32x4*)(red + (((wid * 2 + 1) * 2 + 0) * 16 + n) * 16 + 4 * fq) = a10;
        *(LAS f32x4*)(red + (((wid * 2 + 1) * 2 + 1) * 16 + n) * 16 + 4 * fq) = a11;
        __syncthreads();
#pragma unroll
        for (int j = 0; j < 2; ++j) {
            const int o = tid + 512 * j, row = o >> 5, col = o & 31;
            float v = 0.f;
#pragma unroll
            for (int w = 0; w < 8; ++w) v += red[(((w * 2 + (col >> 4)) * 2 + (row >> 4)) * 16 + (row & 15)) * 16 + (col & 15)];
            f(row, n0 + col, v, ib, kp);
        }
        __syncthreads();
    }
}

constexpr int NPH = 7;
__global__ void __launch_bounds__(512, 2) hymba_fwd(Args args) {
    extern __shared__ __attribute__((aligned(16))) unsigned char lds_raw[];
    LAS unsigned char* lds = (LAS unsigned char*)lds_raw;
    LAS unsigned char* xl = lds + XL_OFF;
    volatile LAS unsigned* MISC = (volatile LAS unsigned*)(lds + MISC_OFF);
    const int tid = threadIdx.x, lane = tid & 63, wid = __builtin_amdgcn_readfirstlane(tid >> 6);
    const int G = gridDim.x, bx = blockIdx.x, vcu = (G % 8 == 0) ? (bx % 8) * (G / 8) + bx / 8 : bx;
    unsigned char* ws = args.ws;
    unsigned* ctl = (unsigned*)(ws + WS_CTL);
    const float* x_p = args.in[0]; const float* x_s = args.in[1]; const float* c128 = args.in[2]; const float* c512 = args.in[3]; const float* c2048 = args.in[4];
    const float* norm_mix = args.in[5]; const float* w_in = args.in[6]; const float* q_norm = args.in[7]; const float* k_norm = args.in[8]; const float* rel_bias = args.in[9];
    const float* v_norm = args.in[10]; const float* gmlp_w = args.in[11]; const float* gmlp_b = args.in[12]; const float* w_out = args.in[13]; const float* norm_ffn = args.in[14];
    const float* w_up = args.in[15]; const float* w_down = args.in[16];
    float* out = args.out;
    bf16_t* WinT = (bf16_t*)(ws + WS_WIN); bf16_t* WoutT = (bf16_t*)(ws + WS_WOUT); bf16_t* WupT = (bf16_t*)(ws + WS_WUP); bf16_t* WdnT = (bf16_t*)(ws + WS_WDN);
    bf16_t* H = (bf16_t*)(ws + WS_H); bf16_t* Z = (bf16_t*)(ws + WS_Z); bf16_t* OG = (bf16_t*)(ws + WS_OG); bf16_t* MIX = (bf16_t*)(ws + WS_MIX); bf16_t* ACT = (bf16_t*)(ws + WS_ACT);
    float* SSQG = (float*)(ws + WS_SSQG); float* LSE = (float*)(ws + WS_LSE); float* SSQ2 = (float*)(ws + WS_SSQ2); float* SSQ2S = (float*)(ws + WS_SSQ2S);

    const P0Weights WP{w_in, w_out, w_up, w_down, norm_ffn, WinT, WoutT, WupT, WdnT};
    for (int u = tid; u < 32; u += 512) MISC[u] = 0u;
    __syncthreads();
    XcdBarrier bar; bar.bar = ctl + CW_BAR + args.li * XCD_BAR_WORDS; bar.x = 0; bar.st = nullptr;
    if (MK_N_LAUNCHES == 1) bar = xcd_barrier_post(ctl + CW_BAR + args.li * XCD_BAR_WORDS, MISC + 8);
    const int lo = args.ph_lo, hi = args.ph_hi;
#define IN(k) (lo <= (k) && (k) < hi)
#ifndef PROBE_DBLBAR
#define PROBE_DBLBAR 0
#endif
#define SEAM(k) do { if (IN(k) && IN((k) + 1)) { xcd_barrier(bar); if (PROBE_DBLBAR) { xcd_barrier(bar); xcd_barrier(bar); } } } while (0)
    const int gw = vcu * 8 + wid, NGW = G * 8;

    if (IN(0)) {
        LAS float* scr = (LAS float*)(lds + wid * 16384);
        f32x4 wreg[8];
        if (gw < P0_I_IN) { const P0Item q0 = p0_sel(WP, gw); p0_load(q0, wreg, lane); }
        for (int it = gw; it < P0_I_IN; it += NGW) {
            const P0Item q = p0_sel(WP, it);
            p0_to_lds(q, wreg, scr, lane);
            if (it + NGW < P0_I_IN) { const P0Item qn = p0_sel(WP, it + NGW); p0_load(qn, wreg, lane); }
            p0_from_lds(q, scr, lane);
        }
        for (int row = gw; row < MPAD; row += NGW) {
            u32x2* hp = (u32x2*)(H + (size_t)row * DM);
            if (row < MV) {
                const f32x4* xr = (const f32x4*)(row < MP ? x_p + (size_t)row * DM : x_s + (size_t)(row - MP) * DM);
                f32x4 v[8]; float s = 0.f;
#pragma unroll
                for (int j = 0; j < 8; ++j) { v[j] = __builtin_nontemporal_load(xr + lane + 64 * j); s += dot4(v[j]); }
                const float rinv = __builtin_amdgcn_rsqf(wave_sum(s) * (1.0f / DM) + EPS);
#pragma unroll
                for (int j = 0; j < 8; ++j) { const f32x4 gn = ((const f32x4*)norm_mix)[lane + 64 * j]; const f32x4 o = v[j] * rinv * gn;
                    u32x2 w; w.x = cvt_pk_bf16(o.x, o.y); w.y = cvt_pk_bf16(o.z, o.w); hp[lane + 64 * j] = w; }
            } else {
#pragma unroll
                for (int j = 0; j < 8; ++j) hp[lane + 64 * j] = (u32x2){0u, 0u};
            }
        }
    }
    SEAM(0);
    if (IN(1)) {
        pg8::Gemm g{H, WinT, MPAD, DIN, DM}; pg8::StaticOrder S; S.init(MPAD, DIN, G, bx);
        pg8::EpiZ E{Z, out, q_norm, k_norm, SSQG};
        pg8::gemm_phase<pg8::EpiZ, pg8::StaticOrder, true, true>(lds, xl, g, S, E);
        __syncthreads();
        {
            LAS float* scr = (LAS float*)(lds + wid * 16384);
            const int nunits = (MPAD / 256) * (DIN / 256), n3 = nunits - 2 * G;
            const int nidle = (n3 > 0 && n3 < G) ? G - n3 : 0;
            constexpr int NDEF = P0_NITEMS - P0_I_IN, TAIL_A = 13;
            const int nearly = nidle * 8 * TAIL_A < NDEF ? nidle * 8 * TAIL_A : 0;
            f32x4 wreg[8];
            for (int pass = 0; pass < 2; ++pass) {
                int first, stride, end;
                if (pass == 0) { if (nearly == 0 || bx < n3) continue; first = ((bx - n3) * 8 + wid); stride = nidle * 8; end = nearly; }
                else { first = nearly + gw; stride = NGW; end = NDEF; }
                if (first < end) { const P0Item q0 = p0_sel(WP, P0_I_IN + first); p0_load(q0, wreg, lane); }
                for (int it = first; it < end; it += stride) {
                    const P0Item q = p0_sel(WP, P0_I_IN + it);
                    p0_to_lds(q, wreg, scr, lane);
                    if (it + stride < end) { const P0Item qn = p0_sel(WP, P0_I_IN + it + stride); p0_load(qn, wreg, lane); }
                    p0_from_lds(q, scr, lane);
                }
            }
        }
    }
    SEAM(1);
    if (IN(2)) {
        const int skip = args.pad;
        if (!(skip & 1)) for (int it = vcu * 3; it < 768; it += 3 * G)
            for (int i = 0; i < 3; ++i) {
                u32x4 kreg[8], vreg[8]; bf16x8 qf[4];
                const AttnDesc d = attn_decode(Z, it + i);
                if (!(skip & 16)) attn_load(d, kreg, vreg, qf, tid, lane, wid);
                else {
#pragma unroll
                    for (int q = 0; q < 8; ++q) { kreg[q] = (u32x4){0x3f803f80u, 0x3f803f80u, 0x3f803f80u, 0x3f803f80u}; vreg[q] = kreg[q]; }
#pragma unroll
                    for (int q = 0; q < 4; ++q) qf[q] = __builtin_bit_cast(bf16x8, kreg[0]);
                }
                if (!(skip & 64)) attn_stage(d, kreg, vreg, lds, xl, rel_bias, tid);
                __syncthreads();
                if (!(skip & 32)) attn_compute(d, qf, lds, xl, OG, LSE, lane, wid);
                __syncthreads();
            }
        if (!(skip & 2)) for (int it = vcu; it < 256; it += G) {
            u32x4 greg[4];
            gate_load(Z, it, greg, tid);
            gate_stage(it, greg, lds, xl, SSQG, tid);
            __syncthreads();
            gate_compute(it, lds, xl, Z, gmlp_w, gmlp_b, v_norm, MIX, lane, wid);
            __syncthreads();
        }
        if (!(skip & 4)) for (int it = vcu; it < 384; it += G) { const int g = it >> 7; sattn_item(xl, Z, g == 0 ? c128 : (g == 1 ? c512 : c2048), rel_bias, OG, LSE, g, it & 127, tid, lane, wid); }
        if (!(skip & 8) && vcu == G - 1) sgate_item(Z, SSQG, gmlp_w, gmlp_b, v_norm, MIX, out, tid);
    }
    SEAM(2);
    if (IN(3)) {
        for (int row = gw; row < MV; row += NGW) {
            const int hh = lane >> 4;
            const float l0 = LSE[((size_t)0 * MPAD + row) * 4 + hh], l1 = LSE[((size_t)1 * MPAD + row) * 4 + hh], l2 = LSE[((size_t)2 * MPAD + row) * 4 + hh];
            const float M = fmaxf(l0, fmaxf(l1, l2));
            float a0 = __builtin_amdgcn_exp2f(l0 - M), a1 = __builtin_amdgcn_exp2f(l1 - M), a2 = __builtin_amdgcn_exp2f(l2 - M);
            const float inv = 1.0f / (a0 + a1 + a2); a0 *= inv; a1 *= inv; a2 *= inv;
            const u32x4 o0 = *(const u32x4*)(OG + ((size_t)0 * MPAD + row) * 512 + 8 * lane), o1 = *(const u32x4*)(OG + ((size_t)1 * MPAD + row) * 512 + 8 * lane), o2 = *(const u32x4*)(OG + ((size_t)2 * MPAD + row) * 512 + 8 * lane);
            u32x4 w;
#pragma unroll
            for (int j = 0; j < 4; ++j) {
                const float lo_ = a0 * bf_lo(o0[j]) + a1 * bf_lo(o1[j]) + a2 * bf_lo(o2[j]);
                const float hi_ = a0 * bf_hi(o0[j]) + a1 * bf_hi(o1[j]) + a2 * bf_hi(o2[j]);
                w[j] = cvt_pk_bf16(lo_, hi_);
            }
            *(u32x4*)(MIX + (size_t)row * DMIX + 8 * lane) = w;
        }
    }
    SEAM(3);
    if (IN(4)) {
        pg8::Gemm g{MIX, WoutT, MP, DM, DMIX}; pg8::StaticOrder S; S.init(MP, DM, G, bx);
        pg8::EpiX1 E{x_p, out, H, SSQ2};
        pg8::gemm_phase<pg8::EpiX1, pg8::StaticOrder, false, true>(lds, xl, g, S, E);
        __syncthreads();
        skinny_gemm(lds, MIX + (size_t)MP * DMIX, WoutT, DMIX, DM, 1, vcu, G, tid, lane, wid, [=](int row, int col, float v, int ib, int) {
            const float x1 = x_s[(size_t)row * DM + col] + v;
            out[OUT_Y + (size_t)(MP + row) * DM + col] = x1;
            H[(size_t)(MP + row) * DM + col] = (bf16_t)(cvt_pk_bf16(x1, 0.f) & 0xffffu);
            float s = x1 * x1;
            s += __shfl_xor(s, 1); s += __shfl_xor(s, 2); s += __shfl_xor(s, 4); s += __shfl_xor(s, 8); s += __shfl_xor(s, 16);
            if ((col & 31) == 0) SSQ2S[row * 64 + ib] = s;
        });
    }
    SEAM(4);
    if (IN(5)) {
        pg8::Gemm g{H, WupT, MP, DFF, DM}; pg8::StaticOrder S; S.init(MP, DFF, G, bx);
        pg8::EpiAct E{ACT, SSQ2};
        pg8::gemm_phase<pg8::EpiAct, pg8::StaticOrder, true, true>(lds, xl, g, S, E);
        __syncthreads();
        LAS float* rs = (LAS float*)xl;
        {
            const int row = tid >> 4, part = tid & 15; float s = 0.f;
#pragma unroll
            for (int j = 0; j < 4; ++j) s += SSQ2S[row * 64 + part * 4 + j];
            s += __shfl_xor(s, 1); s += __shfl_xor(s, 2); s += __shfl_xor(s, 4); s += __shfl_xor(s, 8);
            if (part == 0) rs[row] = __builtin_amdgcn_rsqf(s * (1.0f / DM) + EPS);
        }
        __syncthreads();
        skinny_gemm(lds, H + (size_t)MP * DM, WupT, DM, DFF, 1, vcu, G, tid, lane, wid, [=](int row, int col, float v, int, int) {
            float a = fmaxf(v * rs[row], 0.f); a = a * a;
            ACT[(size_t)(MP + row) * DFF + col] = (bf16_t)(cvt_pk_bf16(a, 0.f) & 0xffffu);
        });
    }
    SEAM(5);
    if (IN(6)) {
        pg8::Gemm g{ACT, WdnT, MP, DM, DFF}; pg8::StaticOrder S; S.init(MP, DM, G, bx);
        pg8::EpiY E{out, H};
        pg8::gemm_phase<pg8::EpiY, pg8::StaticOrder, true, true>(lds, xl, g, S, E);
        __syncthreads();
        skinny_gemm(lds, ACT + (size_t)MP * DFF, WdnT, DFF, DM, 4, vcu, G, tid, lane, wid, [=](int row, int col, float v, int, int) {
            atomicAdd(out + OUT_Y + (size_t)(MP + row) * DM + col, v);
        });
    }
#undef IN
#undef SEAM
}

extern "C" void kernel_launch(void* const* d_in, const int* in_sizes, int n_in, void* d_out, int out_size, void* d_ws, size_t ws_size, hipStream_t stream) {
    static int grid = 0;
    if (grid == 0) {
        if (n_in != 17 || in_sizes[0] != MP * DM || out_size != (int)OUT_END || ws_size < WS_END) {
            fprintf(stderr, "kernel_launch: unexpected shapes: n_in %d in0 %d out %d ws %zu (need %zu); nothing launched\n", n_in, n_in > 0 ? in_sizes[0] : -1, out_size, ws_size, (size_t)WS_END); grid = -1; return; }
        int dev = 0, cus = 0, per_cu = 0;
        if (hipGetDevice(&dev) != hipSuccess || hipDeviceGetAttribute(&cus, hipDeviceAttributeMultiprocessorCount, dev) != hipSuccess) { fprintf(stderr, "kernel_launch: device query failed\n"); grid = -1; return; }
        if (hipFuncSetAttribute((const void*)hymba_fwd, hipFuncAttributeMaxDynamicSharedMemorySize, LDS_BYTES) != hipSuccess) { fprintf(stderr, "kernel_launch: hipFuncSetAttribute failed\n"); grid = -1; return; }
        if (hipOccupancyMaxActiveBlocksPerMultiprocessor(&per_cu, (const void*)hymba_fwd, 512, LDS_BYTES) != hipSuccess || per_cu < 1)
            fprintf(stderr, "kernel_launch: note: occupancy query reports %d workgroups per CU\n", per_cu);
        (void)hipGetLastError();
        grid = cus;
        if (cus < 256) fprintf(stderr, "kernel_launch: built for a 256-CU device (P4 / P6 keep one GEMM unit per workgroup); %d CUs reported\n", cus);
    }
    if (grid < 0) return;
    if (hipMemsetAsync((char*)d_ws + WS_CTL, 0, CTL_ZERO_BYTES, stream) != hipSuccess) { fprintf(stderr, "kernel_launch: memset failed\n"); return; }
    Args a{};
    for (int i = 0; i < 17; ++i) a.in[i] = (const float*)d_in[i];
    a.out = (float*)d_out; a.ws = (unsigned char*)d_ws;
    if (PROBE_LO >= 0) {
        const int lo3[3] = {0, PROBE_LO, PROBE_HI}, hi3[3] = {PROBE_HI, PROBE_HI, NPH};
        for (int li = 0; li < 3; ++li) { a.ph_lo = lo3[li]; a.ph_hi = hi3[li]; a.li = li; a.pad = (li == 1) ? PROBE_SKIP : 0; if (a.ph_lo < a.ph_hi) hipLaunchKernelGGL(hymba_fwd, dim3(grid), dim3(512), LDS_BYTES, stream, a); }
        return;
    }
    for (int li = 0; li < MK_N_LAUNCHES; ++li) {
        if (MK_N_LAUNCHES == 1) { a.ph_lo = 0; a.ph_hi = NPH; } else { a.ph_lo = li; a.ph_hi = li + 1; }
        a.li = 0;
        hipLaunchKernelGGL(hymba_fwd, dim3(grid), dim3(512), LDS_BYTES, stream, a);
        const hipError_t le = hipPeekAtLastError();
        if (le != hipSuccess) { fprintf(stderr, "kernel_launch: launch %d failed: %s\n", li, hipGetErrorName(le)); break; }
    }
}
```

```cpp
#include <hip/hip_runtime.h>
#include <cstdio>
#include <cstdint>

#ifndef MK_N_LAUNCHES
#define MK_N_LAUNCHES 1
#endif
#ifndef PROBE_LO
#define PROBE_LO -1
#define PROBE_HI -1
#endif
#ifndef PROBE_T
#define PROBE_T -1
#define PROBE_T_BX 0
#define PROBE_T_AMP 4
#endif
#ifndef PROBE_SKIP
#define PROBE_SKIP 0
#endif

constexpr int DM = 2048, SEQ = 4096, NB = 2, MP = NB * SEQ  , MS = 32  , MV = MP + MS  , MPAD = 8448  ;
constexpr int DIN = 5632, DMIX = 1024, DFF = 8192;
constexpr int ZQ = 0, ZK = 1536, ZV = 3072, ZU = 4608, ZG = 5120;
constexpr float EPS = 1e-6f;
constexpr float LOG2E = 1.4426950408889634f;
constexpr float QSCALE = 0.08838834764831845f * 1.4426950408889634f;
constexpr size_t OUT_Y = 0;
constexpr size_t OUT_KVP0 = (size_t)MV * DM;
constexpr size_t OUT_KVP1 = OUT_KVP0 + 2 * 2 * 128 * 512;
constexpr size_t OUT_KVP2 = OUT_KVP1 + 2 * 2 * 512 * 512;
constexpr size_t OUT_KVS0 = OUT_KVP2 + 2 * 2 * 2048 * 512;
constexpr size_t OUT_GV = OUT_KVS0 + 3 * 32768;
constexpr size_t OUT_END = OUT_GV + 16384;
static_assert(OUT_END == 22462464, "d_out map");

constexpr size_t MiB = 1u << 20;
constexpr size_t WS_CTL = 0, CTL_ZERO_BYTES = 64 * 1024;
constexpr size_t WS_SSQG = 1 * MiB;
constexpr size_t WS_LSE = WS_SSQG + (size_t)MPAD * 2 * 4;
constexpr size_t WS_SSQ2 = WS_LSE + (size_t)3 * MPAD * 4 * 4;
constexpr size_t WS_SSQ2S = WS_SSQ2 + (size_t)MPAD * 8 * 4;
static_assert(WS_SSQ2S + 32 * 128 * 4 <= 2 * MiB, "small arrays");
constexpr size_t WS_WIN = 2 * MiB, WS_WOUT = 24 * MiB, WS_WUP = 28 * MiB, WS_WDN = 60 * MiB;
constexpr size_t WS_H = 92 * MiB;
constexpr size_t WS_ACT = 125 * MiB;
constexpr size_t WS_Z = WS_ACT;
constexpr size_t WS_OG = WS_Z + (size_t)MPAD * DIN * 2;
constexpr size_t WS_MIX = WS_OG + (size_t)3 * MPAD * 512 * 2;
constexpr size_t WS_END = WS_ACT + (size_t)MPAD * DFF * 2;
static_assert(WS_MIX + (size_t)MPAD * DMIX * 2 <= WS_END && WS_H + (size_t)MPAD * DM * 2 <= WS_ACT && WS_WDN + (size_t)DM * DFF * 2 <= WS_H && WS_WIN + (size_t)DIN * DM * 2 <= WS_WOUT, "d_ws map");
constexpr int CW_BAR = 4096, CW_QUEUE = 2048;

constexpr int RING_BYTES = 131072;
constexpr int XL_OFF = RING_BYTES;
constexpr int XL_BYTES = 12288;
constexpr int MISC_OFF = XL_OFF + XL_BYTES;
constexpr int LDS_BYTES = 147456;
static_assert(MISC_OFF + 128 <= LDS_BYTES, "LDS map");

#define GAS __attribute__((address_space(1)))
#define LAS __attribute__((address_space(3)))
typedef unsigned short bf16_t;
typedef short bf16x8 __attribute__((ext_vector_type(8)));
typedef short s16x4 __attribute__((ext_vector_type(4)));
typedef float f32x4 __attribute__((ext_vector_type(4)));
typedef float f32x2 __attribute__((ext_vector_type(2)));
typedef unsigned u32x4 __attribute__((ext_vector_type(4)));
typedef unsigned u32x2 __attribute__((ext_vector_type(2)));

__device__ __forceinline__ unsigned cvt_pk_bf16(float lo, float hi) { unsigned r; asm volatile("v_cvt_pk_bf16_f32 %0, %1, %2" : "=v"(r) : "v"(lo), "v"(hi)); return r; }
__device__ __forceinline__ float bf_lo(unsigned w) { return __uint_as_float(w << 16); }
__device__ __forceinline__ float bf_hi(unsigned w) { return __uint_as_float(w & 0xffff0000u); }
__device__ __forceinline__ float dot4(f32x4 a) { return (a.x * a.x + a.y * a.y) + (a.z * a.z + a.w * a.w); }
__device__ __forceinline__ float wave_sum(float v) {
#pragma unroll
    for (int o = 1; o < 64; o <<= 1) v += __shfl_xor(v, o);
    return v;
}
__device__ __forceinline__ float wave_max(float v) {
#pragma unroll
    for (int o = 1; o < 64; o <<= 1) v = fmaxf(v, __shfl_xor(v, o));
    return v;
}
#define EPI_BAR() do { asm volatile("s_waitcnt lgkmcnt(0)" ::: "memory"); __builtin_amdgcn_s_barrier(); asm volatile("" ::: "memory"); } while (0)

namespace pg8 {
#define PG8_LAS __attribute__((address_space(3)))
constexpr int BM = 256, BK = 64, HALF = 128, HTB = HALF * BK * 2, STAGE_BYTES = 8 * HTB, NXCD = 8, WGM = 8;
__host__ __device__ __forceinline__ int lds_byte(int r, int c) { const int st = (r >> 4) * 2 + (c >> 5), rr = r & 15, cc = c & 31, ob = rr * 64 + cc * 2; return st * 1024 + (ob ^ (((ob >> 9) & 1) << 5)); }
__host__ __device__ __forceinline__ void stage_rc(int b, int& R, int& C) { const int st = b / 1024, sb = b % 1024, swz = sb ^ (((sb >> 9) & 1) << 5); R = (st >> 1) * 16 + swz / 64; C = (st & 1) * 32 + (swz % 64) / 2; }
__host__ __device__ __forceinline__ int perm32(int rho) { const int n = rho >> 4, i = rho & 15; return 8 * (i >> 2) + 4 * n + (i & 3); }

struct Unit { int pm, pn; };
struct Gemm { const bf16_t* A; const bf16_t* Bt; int M, N, K; };

struct StaticOrder {
    int nM, nN, nwg, G, c;
    __host__ __device__ void init(int M, int N, int G_, int c_) { nM = M / BM; nN = N / BM; nwg = nM * nN; G = G_; c = c_; }
    __host__ __device__ bool next(int i, Unit& u) const {
        const long L = (long)i * G + c; if (L >= nwg) return false;
        int wgid = (int)L; { const int q = nwg / NXCD, r = nwg % NXCD, xcd = wgid % NXCD, off = wgid / NXCD; wgid = (xcd < r ? xcd * (q + 1) : r * (q + 1) + (xcd - r) * q) + off; }
        const int nig = WGM * nN, gid = wgid / nig, fm = gid * WGM, gsz = (nM - fm) < WGM ? (nM - fm) : WGM;
        u.pm = fm + ((wgid % nig) % gsz); u.pn = (wgid % nig) / gsz; return true;
    }
    __device__ __forceinline__ void a_ready(const Unit&) const {}
    __device__ __forceinline__ void done(const Unit&) const {}
};

__device__ __forceinline__ f32x2 gelu_pk(f32x2 v) {
    const f32x2 av = __builtin_elementwise_abs(v), d = av * 0.2316418882f + 1.0f;
    f32x2 t; t.x = __builtin_amdgcn_rcpf(d.x); t.y = __builtin_amdgcn_rcpf(d.y);
    f32x2 q = t * 0.5307027145f + (-0.7265760135f); q = q * t + 0.7107068705f; q = q * t + (-0.142248368f); q = q * t + 0.127414796f; q = q * t;
    const f32x2 s = (v * v) * (-0.72134752044f);
    f32x2 e; e.x = __builtin_amdgcn_exp2f(s.x); e.y = __builtin_amdgcn_exp2f(s.y);
    const f32x2 m = v * (q * e), r = v - m;
    f32x2 o; o.x = v.x < 0.f ? m.x : r.x; o.y = v.y < 0.f ? m.y : r.y; return o;
}
__device__ __forceinline__ f32x4 gelu4(f32x4 v) { const f32x2 a = gelu_pk((f32x2){v.x, v.y}), b = gelu_pk((f32x2){v.z, v.w}); return (f32x4){a.x, a.y, b.x, b.y}; }
__device__ __forceinline__ u32x4 pack8(f32x4 v0, f32x4 v1) { u32x4 w; w.x = cvt_pk_bf16(v0.x, v0.y); w.y = cvt_pk_bf16(v0.z, v0.w); w.z = cvt_pk_bf16(v1.x, v1.y); w.w = cvt_pk_bf16(v1.z, v1.w); return w; }

__device__ __forceinline__ float* kv_dst(float* out, int row, int gi, int kv, int hh) {
    if (row < MP) {
        const int keep = 128 << (2 * gi), b = row >> 12, t = row & 4095, pos = t - (SEQ - keep);
        if (pos < 0) return nullptr;
        const size_t base = gi == 0 ? OUT_KVP0 : (gi == 1 ? OUT_KVP1 : OUT_KVP2);
        return out + base + ((size_t)((b * 2 + kv) * keep + pos) * 4 + hh) * 128;
    }
    const int j = row - MP; if (j >= MS) return nullptr;
    return out + OUT_KVS0 + (size_t)gi * 32768 + ((size_t)(((j >> 2) * 2 + kv) * 4 + (j & 3)) * 4 + hh) * 128;
}

struct EpiZ {
    static constexpr bool PERM = true, AFTER_DRAIN = false;
    bf16_t* Z; float* out; const float* qn; const float* kn; float* ssqg;
    __device__ __forceinline__ void operator()(f32x4 (&acc)[2][2][4][2], const Unit& u, int wr, int wc, int fr, int fq, PG8_LAS unsigned char* xl) const {
        const int pn = u.pn, rowl0 = wr * 64 + fr, cl0 = wc * 32 + 8 * fq;
        PG8_LAS float* P = (PG8_LAS float*)xl;
        if (pn < 12) {
            const bool isq = pn < 6;
#pragma unroll
            for (int ai = 0; ai < 2; ++ai)
#pragma unroll
                for (int m = 0; m < 4; ++m)
#pragma unroll
                    for (int bj = 0; bj < 2; ++bj) {
                        float s = dot4(acc[ai][bj][m][0]) + dot4(acc[ai][bj][m][1]);
                        s += __shfl_xor(s, 16); s += __shfl_xor(s, 32);
                        if (fq == 0) P[((128 * ai + 16 * m + rowl0) * 2 + bj) * 4 + wc] = s;
                    }
            EPI_BAR();
            const float* gp = (isq ? qn : kn) + cl0;
            f32x4 g0 = *(const f32x4*)gp, g1 = *(const f32x4*)(gp + 4);
            if (isq) { g0 = g0 * QSCALE; g1 = g1 * QSCALE; }
            const int cp = isq ? pn : pn - 6, gi = cp >> 1;
#pragma unroll
            for (int ai = 0; ai < 2; ++ai)
#pragma unroll
                for (int m = 0; m < 4; ++m) {
                    const int rowl = 128 * ai + 16 * m + rowl0, row = u.pm * BM + rowl;
#pragma unroll
                    for (int bj = 0; bj < 2; ++bj) {
                        const f32x4 p = *(const PG8_LAS f32x4*)(P + (rowl * 2 + bj) * 4);
                        const float rinv = __builtin_amdgcn_rsqf(((p.x + p.y) + (p.z + p.w)) * (1.0f / 128.0f) + EPS);
                        const f32x4 v0 = acc[ai][bj][m][0] * rinv * g0, v1 = acc[ai][bj][m][1] * rinv * g1;
                        *(u32x4*)(Z + (size_t)row * DIN + pn * BM + bj * HALF + cl0) = pack8(v0, v1);
                        if (!isq) { float* dp = kv_dst(out, row, gi, 0, (cp & 1) * 2 + bj); if (dp) { __builtin_nontemporal_store(v0, (f32x4*)(dp + cl0)); __builtin_nontemporal_store(v1, (f32x4*)(dp + cl0 + 4)); } }
                    }
                }
        } else if (pn < 18) {
            const int cp = pn - 12, gi = cp >> 1;
#pragma unroll
            for (int ai = 0; ai < 2; ++ai)
#pragma unroll
                for (int m = 0; m < 4; ++m) {
                    const int rowl = 128 * ai + 16 * m + rowl0, row = u.pm * BM + rowl;
#pragma unroll
                    for (int bj = 0; bj < 2; ++bj) {
                        const f32x4 v0 = acc[ai][bj][m][0], v1 = acc[ai][bj][m][1];
                        *(u32x4*)(Z + (size_t)row * DIN + pn * BM + bj * HALF + cl0) = pack8(v0, v1);
                        float* dp = kv_dst(out, row, gi, 1, (cp & 1) * 2 + bj); if (dp) { __builtin_nontemporal_store(v0, (f32x4*)(dp + cl0)); __builtin_nontemporal_store(v1, (f32x4*)(dp + cl0 + 4)); }
                    }
                }
        } else {
            const bool isg = pn >= 20;
#pragma unroll
            for (int ai = 0; ai < 2; ++ai)
#pragma unroll
                for (int m = 0; m < 4; ++m) {
                    const int rowl = 128 * ai + 16 * m + rowl0, row = u.pm * BM + rowl;
                    float s = 0.f;
#pragma unroll
                    for (int bj = 0; bj < 2; ++bj) {
                        const f32x4 v0 = gelu4(acc[ai][bj][m][0]), v1 = gelu4(acc[ai][bj][m][1]);
                        s += dot4(v0) + dot4(v1);
                        *(u32x4*)(Z + (size_t)row * DIN + pn * BM + bj * HALF + cl0) = pack8(v0, v1);
                    }
                    if (isg) { s += __shfl_xor(s, 16); s += __shfl_xor(s, 32); if (fq == 0) P[rowl * 4 + wc] = s; }
                }
            if (isg) {
                EPI_BAR();
                const int t = threadIdx.x;
                if (t < 256) { const f32x4 p = *(const PG8_LAS f32x4*)(P + t * 4); ssqg[(size_t)(u.pm * BM + t) * 2 + (pn - 20)] = (p.x + p.y) + (p.z + p.w); }
            }
        }
    }
};
struct EpiX1 {
    static constexpr bool PERM = false, AFTER_DRAIN = true;
    const float* x; float* out; bf16_t* x1b; float* ssq2;
    __device__ __forceinline__ void fused(f32x4 (&acc)[2][2][4][2], const Unit& u, int wr, int wc, int fr, int fq, PG8_LAS unsigned char* xl) const {
        PG8_LAS float* P = (PG8_LAS float*)xl;
        const int rowl0 = wr * 64 + fr, col0 = u.pn * BM + wc * 32 + 4 * fq;
#pragma unroll
        for (int ai = 0; ai < 2; ++ai) {
            f32x4 xv[4][2][2];
#pragma unroll
            for (int m = 0; m < 4; ++m) { const size_t off = (size_t)(u.pm * BM + 128 * ai + 16 * m + rowl0) * DM + col0;
#pragma unroll
                for (int bj = 0; bj < 2; ++bj)
#pragma unroll
                    for (int n = 0; n < 2; ++n) xv[m][bj][n] = __builtin_nontemporal_load((const f32x4*)(x + off + bj * HALF + n * 16)); }
            asm volatile("" ::: "memory");
#pragma unroll
            for (int m = 0; m < 4; ++m) {
                const int rowl = 128 * ai + 16 * m + rowl0; const size_t off = (size_t)(u.pm * BM + rowl) * DM + col0;
                float s = 0.f;
#pragma unroll
                for (int bj = 0; bj < 2; ++bj)
#pragma unroll
                    for (int n = 0; n < 2; ++n) {
                        const size_t o = off + bj * HALF + n * 16;
                        const f32x4 v = xv[m][bj][n] + acc[ai][bj][m][n];
                        s += dot4(v);
                        u32x2 w; w.x = cvt_pk_bf16(v.x, v.y); w.y = cvt_pk_bf16(v.z, v.w); *(u32x2*)(x1b + o) = w;
                    }
                s += __shfl_xor(s, 16); s += __shfl_xor(s, 32);
                if (fq == 0) P[rowl * 4 + wc] = s;
            }
        }
        EPI_BAR();
        const int t = threadIdx.x;
        if (t < 256) { const f32x4 p = *(const PG8_LAS f32x4*)(P + t * 4); ssq2[(size_t)(u.pm * BM + t) * 8 + u.pn] = (p.x + p.y) + (p.z + p.w); }
    }
};
struct EpiAct {
    static constexpr bool PERM = true, AFTER_DRAIN = false;
    bf16_t* act; const float* ssq2;
    __device__ __forceinline__ void operator()(f32x4 (&acc)[2][2][4][2], const Unit& u, int wr, int wc, int fr, int fq, PG8_LAS unsigned char*) const {
        const int rowl0 = wr * 64 + fr, cl0 = wc * 32 + 8 * fq;
        float rv[2][4];
        {
            f32x4 sa[2][4], sb[2][4];
#pragma unroll
            for (int ai = 0; ai < 2; ++ai)
#pragma unroll
                for (int m = 0; m < 4; ++m) { const int row = u.pm * BM + 128 * ai + 16 * m + rowl0; sa[ai][m] = *(const f32x4*)(ssq2 + (size_t)row * 8); sb[ai][m] = *(const f32x4*)(ssq2 + (size_t)row * 8 + 4); }
            asm volatile("" ::: "memory");
#pragma unroll
            for (int ai = 0; ai < 2; ++ai)
#pragma unroll
                for (int m = 0; m < 4; ++m) { const f32x4 a = sa[ai][m], b = sb[ai][m]; rv[ai][m] = __builtin_amdgcn_rsqf((((a.x + a.y) + (a.z + a.w)) + ((b.x + b.y) + (b.z + b.w))) * (1.0f / DM) + EPS); }
        }
#pragma unroll
        for (int ai = 0; ai < 2; ++ai)
#pragma unroll
            for (int m = 0; m < 4; ++m) {
                const int row = u.pm * BM + 128 * ai + 16 * m + rowl0;
                const float rinv = rv[ai][m];
#pragma unroll
                for (int bj = 0; bj < 2; ++bj) {
                    f32x4 v0 = acc[ai][bj][m][0] * rinv, v1 = acc[ai][bj][m][1] * rinv;
                    v0 = __builtin_elementwise_max(v0, (f32x4){0.f, 0.f, 0.f, 0.f}); v1 = __builtin_elementwise_max(v1, (f32x4){0.f, 0.f, 0.f, 0.f});
                    *(u32x4*)(act + (size_t)row * DFF + u.pn * BM + bj * HALF + cl0) = pack8(v0 * v0, v1 * v1);
                }
            }
    }
};
struct EpiY {
    static constexpr bool PERM = false, AFTER_DRAIN = true;
    float* out; const bf16_t* x1b;
    __device__ __forceinline__ void fused(f32x4 (&acc)[2][2][4][2], const Unit& u, int wr, int wc, int fr, int fq, PG8_LAS unsigned char*) const {
        const int rowl0 = wr * 64 + fr, col0 = u.pn * BM + wc * 32 + 4 * fq;
        u32x2 xb[2][4][2][2];
#pragma unroll
        for (int ai = 0; ai < 2; ++ai)
#pragma unroll
            for (int m = 0; m < 4; ++m) { const size_t off = (size_t)(u.pm * BM + 128 * ai + 16 * m + rowl0) * DM + col0;
#pragma unroll
                for (int bj = 0; bj < 2; ++bj)
#pragma unroll
                    for (int n = 0; n < 2; ++n) xb[ai][m][bj][n] = __builtin_nontemporal_load((const u32x2*)(x1b + off + bj * HALF + n * 16)); }
        asm volatile("" ::: "memory");
#pragma unroll
        for (int ai = 0; ai < 2; ++ai)
#pragma unroll
            for (int m = 0; m < 4; ++m) {
                const size_t off = (size_t)(u.pm * BM + 128 * ai + 16 * m + rowl0) * DM + col0;
#pragma unroll
                for (int bj = 0; bj < 2; ++bj)
#pragma unroll
                    for (int n = 0; n < 2; ++n) { const size_t o = off + bj * HALF + n * 16; const u32x2 q = xb[ai][m][bj][n];
                        *(f32x4*)(out + o) = (f32x4){bf_lo(q.x), bf_hi(q.x), bf_lo(q.y), bf_hi(q.y)} + acc[ai][bj][m][n]; }
            }
    }
};

template <class Epi, class Sched, bool ALIGN_EPI = false, bool SP2 = false>
__device__ __forceinline__ void gemm_phase(PG8_LAS unsigned char* lds, PG8_LAS unsigned char* xl, const Gemm g, const Sched& S, const Epi& E) {
    const int tid = threadIdx.x, wid = __builtin_amdgcn_readfirstlane(tid >> 6), lane = tid & 63, wr = wid >> 2, wc = wid & 3, fr = lane & 15, fq = lane >> 4;
    const int K = g.K, nt = K / BK;
    unsigned voffA[2], voffB[2];
#pragma unroll
    for (int i = 0; i < 2; ++i) { int R, C; stage_rc(tid * 16 + i * 8192, R, C); const int Rb = Epi::PERM ? ((R & ~31) + perm32(R & 31)) : R;
        voffA[i] = (unsigned)(R * K + C) * 2u; voffB[i] = (unsigned)(Rb * K + C) * 2u; }
    const size_t kstep = (size_t)(BK * 2);
    const size_t hstep = (size_t)HALF * K * 2;
    const size_t tstep = 2 * hstep;
    const unsigned ldsw = (unsigned)wid * 1024u;
    const int aoff = lds_byte(wr * 64 + fr, fq * 8), boff = lds_byte(wc * 32 + fr, fq * 8);
#define PG8_SA(b, h) (((b) * 2 + (h)) * HTB)
#define PG8_SB(b, h) ((4 + (b) * 2 + (h)) * HTB)
#define PG8_STAGE(bufoff, gbase, voff) do { _Pragma("unroll") for (int _i = 0; _i < 2; ++_i) \
        __builtin_amdgcn_global_load_lds((const unsigned*)((const char*)(gbase) + (voff)[_i]), (PG8_LAS unsigned*)(lds + (bufoff) + ldsw + _i * 8192), 16, 0, 0); } while (0)
#define PG8_LDA(dst, b, h) do { _Pragma("unroll") for (int m = 0; m < 4; ++m) _Pragma("unroll") for (int k = 0; k < 2; ++k) dst[m][k] = *(const PG8_LAS bf16x8*)(lds + PG8_SA(b, h) + aoff + m * 2048 + k * 1024); } while (0)
#define PG8_LDB(dst, b, h) do { _Pragma("unroll") for (int n = 0; n < 2; ++n) _Pragma("unroll") for (int k = 0; k < 2; ++k) dst[n][k] = *(const PG8_LAS bf16x8*)(lds + PG8_SB(b, h) + boff + n * 2048 + k * 1024); } while (0)
#define PG8_MMA(ai, bj, At, Bt) do { __builtin_amdgcn_s_setprio(1); _Pragma("unroll") for (int m = 0; m < 4; ++m) _Pragma("unroll") for (int n = 0; n < 2; ++n) _Pragma("unroll") for (int k = 0; k < 2; ++k) \
        acc[ai][bj][m][n] = __builtin_amdgcn_mfma_f32_16x16x32_bf16(Bt[n][k], At[m][k], acc[ai][bj][m][n], 0, 0, 0); __builtin_amdgcn_s_setprio(0); } while (0)
#define PG8_WAIT_V(n) asm volatile("s_waitcnt vmcnt(" #n ")" ::: "memory")
#define PG8_WAIT_L(n) asm volatile("s_waitcnt lgkmcnt(" #n ")" ::: "memory")
#define PG8_BAR __builtin_amdgcn_s_barrier()
#define PG8_SCHED __builtin_amdgcn_sched_barrier(0)
    Unit cur, nxt; int ui = 0;
    if (!S.next(0, cur)) return;
    f32x4 acc[2][2][4][2];
#pragma unroll
    for (int a = 0; a < 2; ++a)
#pragma unroll
        for (int b = 0; b < 2; ++b)
#pragma unroll
            for (int m = 0; m < 4; ++m)
#pragma unroll
                for (int n = 0; n < 2; ++n) acc[a][b][m][n] = (f32x4){0.f, 0.f, 0.f, 0.f};
    bf16x8 At[4][2], B0[2][2], B1[2][2];
    const char* cA = (const char*)g.A + (size_t)cur.pm * tstep; const char* cB = (const char*)g.Bt + (size_t)cur.pn * tstep;
    S.a_ready(cur);
    if constexpr (SP2) {
        PG8_STAGE(PG8_SB(0, 0), cB, voffB); PG8_STAGE(PG8_SB(0, 1), cB + hstep, voffB); PG8_STAGE(PG8_SA(0, 0), cA, voffA); PG8_STAGE(PG8_SA(0, 1), cA + hstep, voffA);
        if (wr == 1) PG8_BAR;
        PG8_WAIT_V(2); PG8_BAR;
        PG8_STAGE(PG8_SB(1, 0), cB + kstep, voffB); PG8_STAGE(PG8_SA(1, 0), cA + kstep, voffA); PG8_STAGE(PG8_SB(1, 1), cB + hstep + kstep, voffB);
        PG8_WAIT_V(6); PG8_BAR;
    } else {
        PG8_STAGE(PG8_SB(0, 0), cB, voffB); PG8_STAGE(PG8_SA(0, 0), cA, voffA); PG8_STAGE(PG8_SB(0, 1), cB + hstep, voffB); PG8_STAGE(PG8_SA(0, 1), cA + hstep, voffA);
        if (wr == 1) PG8_BAR;
        PG8_WAIT_V(4); PG8_BAR;
        PG8_STAGE(PG8_SB(1, 0), cB + kstep, voffB); PG8_STAGE(PG8_SA(1, 0), cA + kstep, voffA); PG8_STAGE(PG8_SB(1, 1), cB + hstep + kstep, voffB);
        PG8_WAIT_V(6); PG8_BAR;
    }
    for (;;) {
        const bool has_next = S.next(ui + 1, nxt);
        const char* nA = has_next ? (const char*)g.A + (size_t)nxt.pm * tstep : cA; const char* nB = has_next ? (const char*)g.Bt + (size_t)nxt.pn * tstep : cB;
        for (int t = 0; t < nt; t += 2) {
            const bool last = (t == nt - 2);
            const char* a1 = cA + (size_t)(t + 1) * kstep;
            const char* a2 = last ? nA : cA + (size_t)(t + 2) * kstep; const char* b2 = last ? nB : cB + (size_t)(t + 2) * kstep;
            const char* a3 = a2 + kstep; const char* b3 = b2 + kstep;
            if (last && has_next) S.a_ready(nxt);
            if constexpr (SP2) {
            PG8_LDB(B0, 0, 0); PG8_LDB(B1, 0, 1); PG8_SCHED; PG8_LDA(At, 0, 0); PG8_STAGE(PG8_SA(1, 1), a1 + hstep, voffA);
            PG8_WAIT_V(8); PG8_WAIT_L(0); PG8_BAR; PG8_MMA(0, 0, At, B0); PG8_MMA(0, 1, At, B1); PG8_BAR; PG8_SCHED;
            PG8_LDA(At, 0, 1); PG8_STAGE(PG8_SB(0, 0), b2, voffB); PG8_STAGE(PG8_SB(0, 1), b2 + hstep, voffB); PG8_STAGE(PG8_SA(0, 0), a2, voffA);
            PG8_WAIT_V(8); PG8_WAIT_L(0); PG8_BAR; PG8_MMA(1, 0, At, B0); PG8_MMA(1, 1, At, B1); PG8_BAR; PG8_SCHED;
            PG8_LDB(B0, 1, 0); PG8_LDB(B1, 1, 1); PG8_SCHED; PG8_LDA(At, 1, 0); PG8_STAGE(PG8_SA(0, 1), a2 + hstep, voffA);
            PG8_WAIT_V(8); PG8_WAIT_L(0); PG8_BAR; PG8_MMA(0, 0, At, B0); PG8_MMA(0, 1, At, B1); PG8_BAR; PG8_SCHED;
            PG8_LDA(At, 1, 1); PG8_STAGE(PG8_SB(1, 0), b3, voffB); PG8_STAGE(PG8_SB(1, 1), b3 + hstep, voffB); PG8_STAGE(PG8_SA(1, 0), a3, voffA);
            PG8_WAIT_V(8); PG8_WAIT_L(0); PG8_BAR; PG8_MMA(1, 0, At, B0); PG8_MMA(1, 1, At, B1); PG8_BAR; PG8_SCHED;
            } else {
            PG8_LDB(B0, 0, 0); PG8_SCHED; PG8_LDA(At, 0, 0); PG8_STAGE(PG8_SA(1, 1), a1 + hstep, voffA);
            PG8_WAIT_L(8); PG8_BAR; PG8_WAIT_L(0); PG8_MMA(0, 0, At, B0); PG8_BAR; PG8_SCHED;
            PG8_LDB(B1, 0, 1); PG8_STAGE(PG8_SB(0, 0), b2, voffB);
            PG8_BAR; PG8_WAIT_L(0); PG8_MMA(0, 1, At, B1); PG8_BAR;
            PG8_LDA(At, 0, 1); PG8_STAGE(PG8_SA(0, 0), a2, voffA);
            PG8_BAR; PG8_WAIT_L(0); PG8_MMA(1, 0, At, B0); PG8_BAR; PG8_SCHED;
            PG8_STAGE(PG8_SB(0, 1), b2 + hstep, voffB);
            PG8_WAIT_V(6); PG8_BAR; PG8_MMA(1, 1, At, B1); PG8_BAR;
            PG8_LDB(B0, 1, 0); PG8_SCHED; PG8_LDA(At, 1, 0); PG8_STAGE(PG8_SA(0, 1), a2 + hstep, voffA);
            PG8_WAIT_L(8); PG8_BAR; PG8_WAIT_L(0); PG8_MMA(0, 0, At, B0); PG8_BAR; PG8_SCHED;
            PG8_LDB(B1, 1, 1); PG8_STAGE(PG8_SB(1, 0), b3, voffB);
            PG8_BAR; PG8_WAIT_L(0); PG8_MMA(0, 1, At, B1); PG8_BAR;
            PG8_LDA(At, 1, 1); PG8_STAGE(PG8_SA(1, 0), a3, voffA);
            PG8_BAR; PG8_WAIT_L(0); PG8_MMA(1, 0, At, B0); PG8_BAR; PG8_SCHED;
            PG8_STAGE(PG8_SB(1, 1), b3 + hstep, voffB);
            PG8_WAIT_V(6); PG8_BAR; PG8_MMA(1, 1, At, B1); PG8_BAR;
            }
        }
        if constexpr (ALIGN_EPI) { if (wr == 0) PG8_BAR; }
        if constexpr (!Epi::AFTER_DRAIN) { E(acc, cur, wr, wc, fr, fq, xl); S.done(cur); }
        if (!has_next) break;
#pragma unroll
        for (int a = 0; a < 2; ++a)
#pragma unroll
            for (int b = 0; b < 2; ++b)
#pragma unroll
                for (int m = 0; m < 4; ++m)
#pragma unroll
                    for (int n = 0; n < 2; ++n) acc[a][b][m][n] = (f32x4){0.f, 0.f, 0.f, 0.f};
        cur = nxt; cA = nA; cB = nB; ++ui;
        if constexpr (ALIGN_EPI) { if (wr == 1) PG8_BAR; }
    }
    PG8_WAIT_V(0);
    if constexpr (!ALIGN_EPI) { if (wr == 0) PG8_BAR; }
    PG8_BAR;
    if constexpr (Epi::AFTER_DRAIN) { E.fused(acc, cur, wr, wc, fr, fq, xl); S.done(cur); }
#undef PG8_SA
#undef PG8_SB
#undef PG8_STAGE
#undef PG8_LDA
#undef PG8_LDB
#undef PG8_MMA
#undef PG8_WAIT_V
#undef PG8_WAIT_L
#undef PG8_BAR
#undef PG8_SCHED
}
}

typedef GAS unsigned gu32;
#define RLX_AGENT __ATOMIC_RELAXED, __HIP_MEMORY_SCOPE_AGENT
#define XB_TMO      128
#define XB_XCNT(j)  (256  + 64 * (j))
#define XB_XSUB(j)  (1280 + 64 * (j))
#define XB_XGEN(j)  (2304 + 64 * (j))
#define XB_TOP      3328
#define XB_TOPGEN   3392
#define XCD_BAR_WORDS 3456
#define XB_SPIN_CAP (1u << 18)
__device__ __forceinline__ unsigned xb_ld(unsigned* p)              { return __hip_atomic_load(p, __ATOMIC_RELAXED, __HIP_MEMORY_SCOPE_AGENT); }
__device__ __forceinline__ unsigned xb_add(unsigned* p, unsigned v) { return __hip_atomic_fetch_add(p, v, __ATOMIC_RELAXED, __HIP_MEMORY_SCOPE_AGENT); }
__device__ __forceinline__ unsigned xb_xcc_id() { return (unsigned)__builtin_amdgcn_s_getreg((3 << 11) | 20) & 0xFu; }
#define XB_SPIN(cond, bar) do { unsigned _sp = 0; while (cond) { __builtin_amdgcn_s_sleep(1); \
    if ((++_sp & 255u) == 0u) { if (xb_ld(&(bar)[XB_TMO])) break; if (_sp > XB_SPIN_CAP) { atomicAdd(&(bar)[XB_TMO], 1u); break; } } } } while (0)
struct XcdBarrier { unsigned* bar; unsigned x; volatile LAS unsigned* st; };
__device__ __forceinline__ XcdBarrier xcd_barrier_post(unsigned* bar, volatile LAS unsigned* st) {
    XcdBarrier b; b.bar = bar; b.x = xb_xcc_id(); b.st = st;
    if (threadIdx.x == 0) (void)xb_add(&bar[XB_XCNT(b.x)], 1u);
    return b;
}
__device__ __forceinline__ void xcd_barrier_complete(unsigned* bar, unsigned x, unsigned& nloc, unsigned& nx) {
    const unsigned G = gridDim.x * gridDim.y * gridDim.z;
    unsigned sum, cnt, mine, sp = 0u;
    for (;;) {
        sum = 0u; cnt = 0u; mine = 0u;
#pragma unroll
        for (unsigned j = 0; j < 16; ++j) { const unsigned c = xb_ld(&bar[XB_XCNT(j)]); sum += c; cnt += (c > 0u) ? 1u : 0u; mine = (j == x) ? c : mine; }
        if (sum == G) break;
        __builtin_amdgcn_s_sleep(1);
        if ((++sp & 255u) == 0u) { if (xb_ld(&bar[XB_TMO])) break; if (sp > XB_SPIN_CAP) { atomicAdd(&bar[XB_TMO], 1u); break; } }
    }
    nloc = mine > 0u ? mine : 1u; nx = cnt > 0u ? cnt : 1u;
}
__device__ __forceinline__ void xcd_barrier_drain() {
    asm volatile("s_waitcnt vmcnt(0)" ::: "memory");
    __syncthreads();
}
__device__ __forceinline__ void xcd_barrier_sync(const XcdBarrier& b) {
    if (threadIdx.x == 0) {
        unsigned* bar = b.bar;
        __builtin_amdgcn_s_waitcnt(0);
        unsigned nloc = b.st[0], nx = b.st[1];
        if (nloc == 0u) { xcd_barrier_complete(bar, b.x, nloc, nx); b.st[0] = nloc; b.st[1] = nx; }
        const unsigned old = xb_add(&bar[XB_XSUB(b.x)], 1u);
        const unsigned gen = old / nloc;
        if (old + 1u == (gen + 1u) * nloc) {
            __builtin_amdgcn_fence(__ATOMIC_RELEASE, "agent");
            asm volatile("s_waitcnt vmcnt(0)" ::: "memory");
            const unsigned og = xb_add(&bar[XB_TOP], 1u);
            const unsigned tg = og / nx;
            if (og + 1u == (tg + 1u) * nx) xb_add(&bar[XB_TOPGEN], 1u);
            else XB_SPIN(xb_ld(&bar[XB_TOPGEN]) == tg, bar);
            __builtin_amdgcn_fence(__ATOMIC_ACQUIRE, "agent");
            xb_add(&bar[XB_XGEN(b.x)], 1u);
            asm volatile("s_waitcnt vmcnt(0)" ::: "memory");
        } else {
            XB_SPIN(xb_ld(&bar[XB_XGEN(b.x)]) == gen, bar);
            __builtin_amdgcn_fence(__ATOMIC_ACQUIRE, "agent");
            asm volatile("s_waitcnt vmcnt(0)" ::: "memory");
        }
    }
    __syncthreads();
}
__device__ __forceinline__ void xcd_barrier(const XcdBarrier& b) { xcd_barrier_drain(); xcd_barrier_sync(b); }

#define LDS_WAIT() asm volatile("s_waitcnt lgkmcnt(0)" ::: "memory")
__device__ __forceinline__ int t5_bucket(int dist) {
    if (dist < 16) return dist;
    const float v = log2f((float)dist * (1.0f / 16.0f)) * (16.0f / 7.0f);
    const int b = 16 + (int)v;
    return b > 31 ? 31 : b;
}
typedef short v4i16_t __attribute__((ext_vector_type(4)));
__device__ __forceinline__ s16x4 tr4(const LAS unsigned char* p) { return __builtin_bit_cast(s16x4, __builtin_amdgcn_ds_read_tr16_b64_v4i16((LAS v4i16_t*)p)); }
__device__ __forceinline__ int kswz(int j) { return ((j >> 1) & 12) | (j & 3); }
__device__ __forceinline__ int vswz(int j) { return (j & 3) | (((j >> 3) & 1) << 2); }

struct P0Item { const float* W; bf16_t* WT; const float* sc; int K, N, k0, n0; };
__device__ __forceinline__ void p0_load(const P0Item& q, f32x4 (&w)[8], int lane) {
    const float* p = q.W + (size_t)(q.k0 + (lane >> 3)) * q.N + q.n0 + 4 * (lane & 7);
#pragma unroll
    for (int i = 0; i < 8; ++i) w[i] = __builtin_nontemporal_load((const f32x4*)(p + (size_t)(8 * i) * q.N));
}
__device__ __forceinline__ void p0_to_lds(const P0Item& q, const f32x4 (&w)[8], LAS float* scr, int lane) {
#pragma unroll
    for (int i = 0; i < 8; ++i) { const int kk = 8 * i + (lane >> 3); f32x4 v = w[i]; if (q.sc) v = v * q.sc[q.k0 + kk];
        LAS float* d = scr + kk * 33 + 4 * (lane & 7); d[0] = v.x; d[1] = v.y; d[2] = v.z; d[3] = v.w; }
    LDS_WAIT(); asm volatile("" ::: "memory");
}
__device__ __forceinline__ void p0_from_lds(const P0Item& q, LAS float* scr, int lane) {
    const int c = lane & 7;
#pragma unroll
    for (int j = 0; j < 4; ++j) { const int n = (lane >> 3) + 8 * j; const LAS float* s = scr + (8 * c) * 33 + n;
        u32x4 o; o.x = cvt_pk_bf16(s[0 * 33], s[1 * 33]); o.y = cvt_pk_bf16(s[2 * 33], s[3 * 33]); o.z = cvt_pk_bf16(s[4 * 33], s[5 * 33]); o.w = cvt_pk_bf16(s[6 * 33], s[7 * 33]);
        *(u32x4*)(q.WT + (size_t)(q.n0 + n) * q.K + q.k0 + 8 * c) = o; }
    LDS_WAIT(); asm volatile("" ::: "memory");
}

constexpr int P0_I_IN = (DM / 64) * (DIN / 32), P0_I_OUT = (DMIX / 64) * (DM / 32), P0_I_UP = (DM / 64) * (DFF / 32), P0_I_DN = (DFF / 64) * (DM / 32);
constexpr int P0_NITEMS = P0_I_IN + P0_I_OUT + P0_I_UP + P0_I_DN;
struct P0Weights { const float *w_in, *w_out, *w_up, *w_down, *norm_ffn; bf16_t *WinT, *WoutT, *WupT, *WdnT; };
__device__ __forceinline__ P0Item p0_sel(const P0Weights& w, int it) {
    P0Item q; int r = it;
    if (r < P0_I_IN) { q.W = w.w_in; q.WT = w.WinT; q.sc = nullptr; q.K = DM; q.N = DIN; }
    else if ((r -= P0_I_IN) < P0_I_OUT) { q.W = w.w_out; q.WT = w.WoutT; q.sc = nullptr; q.K = DMIX; q.N = DM; }
    else if ((r -= P0_I_OUT) < P0_I_UP) { q.W = w.w_up; q.WT = w.WupT; q.sc = w.norm_ffn; q.K = DM; q.N = DFF; }
    else { r -= P0_I_UP; q.W = w.w_down; q.WT = w.WdnT; q.sc = nullptr; q.K = DFF; q.N = DM; }
    const int nblk = q.N / 32; q.k0 = 64 * (r / nblk); q.n0 = 32 * (r % nblk); return q;
}
struct Args {
    const float* in[17]; float* out; unsigned char* ws; int ph_lo, ph_hi, li, pad;
};

struct AttnDesc { int g, b, hh, r, blk, dil; const bf16_t* Zb; size_t kstride; };
__device__ __forceinline__ AttnDesc attn_decode(const bf16_t* Z, int item) {
    AttnDesc d; d.g = item >> 8; const int rem = item & 255; d.b = rem >> 7; d.hh = (rem >> 5) & 3; const int rb = rem & 31, sh = 2 * d.g;
    d.dil = 1 << sh; d.r = rb >> (5 - sh); d.blk = rb & ((32 >> sh) - 1);
    d.kstride = (size_t)d.dil * DIN;
    d.Zb = Z + (size_t)(d.b * SEQ + d.r) * DIN + d.g * 512 + d.hh * 128;
    return d;
}
__device__ __forceinline__ void attn_load(const AttnDesc& d, u32x4 (&kreg)[8], u32x4 (&vreg)[8], bf16x8 (&qf)[4], int tid, int lane, int wid) {
    const int n = lane & 15, fq = lane >> 4, iq = 16 * wid + n;
    const bf16_t* qsrc = d.Zb + (size_t)(128 * d.blk + iq) * d.kstride + 8 * fq;
#pragma unroll
    for (int ks = 0; ks < 4; ++ks) qf[ks] = *(const bf16x8*)(qsrc + 32 * ks);
    const int j0 = tid >> 4, c = tid & 15;
    const bf16_t* src0 = d.Zb + (size_t)((long)(128 * (d.blk - 1) + j0)) * d.kstride + c * 8;
    const size_t istep = 32 * d.kstride;
#pragma unroll
    for (int i = 0; i < 8; ++i) {
        if (d.blk > 0 || i >= 4) { const bf16_t* src = src0 + i * istep; kreg[i] = *(const u32x4*)(src + ZK); vreg[i] = *(const u32x4*)(src + ZV); }
        else { kreg[i] = (u32x4){0u, 0u, 0u, 0u}; vreg[i] = kreg[i]; }
    }
}
__device__ __forceinline__ void attn_stage(const AttnDesc& d, const u32x4 (&kreg)[8], const u32x4 (&vreg)[8], LAS unsigned char* lds, LAS unsigned char* xl, const float* relb, int tid) {
    LAS unsigned char* Kl = lds; LAS unsigned char* Vl = lds + 65536; LAS float* bl = (LAS float*)xl;
    const int j0 = tid >> 4, c = tid & 15;
    LAS unsigned char* kd = Kl + j0 * 256 + ((c ^ kswz(j0)) << 4);
    LAS unsigned char* vd = Vl + j0 * 256 + ((((c >> 1) ^ vswz(j0)) << 5) | ((c & 1) << 4));
#pragma unroll
    for (int i = 0; i < 8; ++i) { *(LAS u32x4*)(kd + i * 8192) = kreg[i]; *(LAS u32x4*)(vd + i * 8192) = vreg[i]; }
    if (tid < 192) { const int dist = tid - 32; bl[tid] = (dist >= 0 && dist <= 128) ? relb[t5_bucket(dist * d.dil) * 12 + d.g * 4 + d.hh] * LOG2E : -INFINITY; }
}
__device__ __forceinline__ void attn_compute(const AttnDesc& d, const bf16x8 (&qf)[4], LAS unsigned char* lds, LAS unsigned char* xl, bf16_t* OG, float* LSE, int lane, int wid) {
    const LAS unsigned char* Kl = lds; const LAS unsigned char* Vl = lds + 65536; const LAS float* bl = (const LAS float*)xl;
    const int n = lane & 15, fq = lane >> 4, iq = 16 * wid + n, blk = d.blk;
    const int G0 = wid >> 1;
    f32x4 sc[5][2];
#pragma unroll
    for (int gi = 0; gi < 5; ++gi) {
        const int G = G0 + gi;
        sc[gi][0] = (f32x4){0.f, 0.f, 0.f, 0.f}; sc[gi][1] = sc[gi][0];
        if (blk == 0 && G < 4) { sc[gi][0] = (f32x4){-INFINITY, -INFINITY, -INFINITY, -INFINITY}; sc[gi][1] = sc[gi][0]; }
        else {
#pragma unroll
            for (int bb = 0; bb < 2; ++bb) {
                const LAS unsigned char* kp = Kl + (32 * G + 8 * (n >> 2) + 4 * bb + (n & 3)) * 256;
#pragma unroll
                for (int ks = 0; ks < 4; ++ks) {
                    const bf16x8 kf = *(const LAS bf16x8*)(kp + (((4 * ks + fq) ^ n) << 4));
                    sc[gi][bb] = __builtin_amdgcn_mfma_f32_16x16x32_bf16(kf, qf[ks], sc[gi][bb], 0, 0, 0);
                }
            }
        }
        __builtin_amdgcn_sched_barrier(0);
    }
    float mx = -INFINITY;
    const LAS float* blp = bl + (iq + 128 + 32 - 32 * G0 - 8 * fq);
#pragma unroll
    for (int gi = 0; gi < 5; ++gi)
#pragma unroll
        for (int bb = 0; bb < 2; ++bb)
#pragma unroll
            for (int e = 0; e < 4; ++e) {
                const float s = sc[gi][bb][e] + blp[-(32 * gi + 4 * bb + e)];
                sc[gi][bb][e] = s; mx = fmaxf(mx, s);
            }
    mx = fmaxf(mx, __shfl_xor(mx, 16)); mx = fmaxf(mx, __shfl_xor(mx, 32));
    float l = 0.f;
    bf16x8 pf[5];
#pragma unroll
    for (int gi = 0; gi < 5; ++gi) {
        float p[8];
#pragma unroll
        for (int bb = 0; bb < 2; ++bb)
#pragma unroll
            for (int e = 0; e < 4; ++e) { p[4 * bb + e] = __builtin_amdgcn_exp2f(sc[gi][bb][e] - mx); l += p[4 * bb + e]; }
        u32x4 w; w.x = cvt_pk_bf16(p[0], p[1]); w.y = cvt_pk_bf16(p[2], p[3]); w.z = cvt_pk_bf16(p[4], p[5]); w.w = cvt_pk_bf16(p[6], p[7]);
        pf[gi] = __builtin_bit_cast(bf16x8, w);
    }
    l += __shfl_xor(l, 16); l += __shfl_xor(l, 32);
    f32x4 oacc[8];
#pragma unroll
    for (int db = 0; db < 8; ++db) oacc[db] = (f32x4){0.f, 0.f, 0.f, 0.f};
    const int sv = (n >> 2) | ((fq & 1) << 2);
#pragma unroll
    for (int gi = 0; gi < 5; ++gi) {
        const int G = G0 + gi;
        if (blk > 0 || G >= 4) {
            const LAS unsigned char* vp = Vl + (32 * G + 8 * fq + (n >> 2)) * 256 + 8 * (n & 3);
#pragma unroll
            for (int db = 0; db < 8; ++db) {
                const LAS unsigned char* a = vp + ((db ^ sv) << 5);
                const s16x4 lo = tr4(a), hi = tr4(a + 1024);
                const bf16x8 vf = (bf16x8){lo[0], lo[1], lo[2], lo[3], hi[0], hi[1], hi[2], hi[3]};
                oacc[db] = __builtin_amdgcn_mfma_f32_16x16x32_bf16(vf, pf[gi], oacc[db], 0, 0, 0);
            }
        }
        __builtin_amdgcn_sched_barrier(0);
    }
    const float inv = 1.0f / l;
    const size_t row = (size_t)(d.b * SEQ + d.r) + (size_t)d.dil * (128 * blk + iq);
    bf16_t* op = OG + ((size_t)d.g * MPAD + row) * 512 + d.hh * 128 + 4 * fq;
#pragma unroll
    for (int db = 0; db < 8; ++db) { u32x2 w; w.x = cvt_pk_bf16(oacc[db].x * inv, oacc[db].y * inv); w.y = cvt_pk_bf16(oacc[db].z * inv, oacc[db].w * inv); *(u32x2*)(op + 16 * db) = w; }
    if (fq == 0) LSE[((size_t)d.g * MPAD + row) * 4 + d.hh] = mx + log2f(l);
}

__device__ __forceinline__ void gate_load(const bf16_t* Z, int item, u32x4 (&greg)[4], int tid) {
    const int b = item >> 7, nc = (item >> 2) & 31, g = item & 3, row0 = b * SEQ + 128 * nc;
    const bf16_t* src0 = Z + (size_t)(row0 + (tid >> 4)) * DIN + ZG + g * 128 + (tid & 15) * 8;
#pragma unroll
    for (int i = 0; i < 4; ++i) greg[i] = *(const u32x4*)(src0 + (size_t)i * 32 * DIN);
}
__device__ __forceinline__ void gate_stage(int item, const u32x4 (&greg)[4], LAS unsigned char* lds, LAS unsigned char* xl, const float* ssqg, int tid) {
    const int b = item >> 7, nc = (item >> 2) & 31, row0 = b * SEQ + 128 * nc;
    LAS unsigned char* Gl = lds; LAS float* rl = (LAS float*)xl;
    const int j0 = tid >> 4, c = tid & 15;
    LAS unsigned char* gd = Gl + j0 * 256 + ((((c >> 1) ^ vswz(j0)) << 5) | ((c & 1) << 4));
#pragma unroll
    for (int i = 0; i < 4; ++i) *(LAS u32x4*)(gd + i * 8192) = greg[i];
    if (tid < 128) rl[tid] = __builtin_amdgcn_rsqf((ssqg[(size_t)(row0 + tid) * 2] + ssqg[(size_t)(row0 + tid) * 2 + 1]) * (1.0f / 512.0f) + EPS);
}
__device__ __forceinline__ void gate_compute(int item, LAS unsigned char* lds, LAS unsigned char* xl, const bf16_t* Z, const float* gw, const float* gb, const float* vn, bf16_t* MIX, int lane, int wid) {
    const int b = item >> 7, nc = (item >> 2) & 31, g = item & 3, row0 = b * SEQ + 128 * nc;
    const LAS unsigned char* Gl = lds; const LAS float* rl = (const LAS float*)xl;
    const int n = lane & 15, fq = lane >> 4, t = 16 * wid + n;
    f32x4 acc[8];
#pragma unroll
    for (int cb = 0; cb < 8; ++cb) acc[cb] = (f32x4){0.f, 0.f, 0.f, 0.f};
    const int sv = (n >> 2) | ((fq & 1) << 2);
#pragma unroll
    for (int ks = 0; ks < 4; ++ks) {
        if (ks <= (wid >> 1)) {
            const int s0 = 32 * ks + 8 * fq;
            const float* wp = gw + ((size_t)g * 128 + t) * 128 + s0;
            const f32x4 w0 = *(const f32x4*)wp, w1 = *(const f32x4*)(wp + 4);
            const f32x4 r0 = *(const LAS f32x4*)(rl + s0), r1 = *(const LAS f32x4*)(rl + s0 + 4);
            float wv[8] = {w0.x * r0.x, w0.y * r0.y, w0.z * r0.z, w0.w * r0.w, w1.x * r1.x, w1.y * r1.y, w1.z * r1.z, w1.w * r1.w};
#pragma unroll
            for (int e = 0; e < 8; ++e) wv[e] = (s0 + e <= t) ? wv[e] : 0.f;
            u32x4 w; w.x = cvt_pk_bf16(wv[0], wv[1]); w.y = cvt_pk_bf16(wv[2], wv[3]); w.z = cvt_pk_bf16(wv[4], wv[5]); w.w = cvt_pk_bf16(wv[6], wv[7]);
            const bf16x8 wf = __builtin_bit_cast(bf16x8, w);
            const LAS unsigned char* vp = Gl + (32 * ks + 8 * fq + (n >> 2)) * 256 + 8 * (n & 3);
#pragma unroll
            for (int cb = 0; cb < 8; ++cb) {
                const LAS unsigned char* a = vp + ((cb ^ sv) << 5);
                const s16x4 lo = tr4(a), hi = tr4(a + 1024);
                const bf16x8 gf = (bf16x8){lo[0], lo[1], lo[2], lo[3], hi[0], hi[1], hi[2], hi[3]};
                acc[cb] = __builtin_amdgcn_mfma_f32_16x16x32_bf16(gf, wf, acc[cb], 0, 0, 0);
            }
        }
    }
    const float bt = gb[g * 128 + t];
    const bf16_t* up = Z + (size_t)(row0 + t) * DIN + ZU + g * 128 + 4 * fq;
    bf16_t* mp = MIX + (size_t)(row0 + t) * DMIX + 512 + g * 128 + 4 * fq;
#pragma unroll
    for (int cb = 0; cb < 8; ++cb) {
        const f32x4 gn = *(const f32x4*)(vn + g * 128 + 16 * cb + 4 * fq);
        const u32x2 uu = *(const u32x2*)(up + 16 * cb);
        const f32x4 mixed = acc[cb] * gn + bt;
        u32x2 w; w.x = cvt_pk_bf16(bf_lo(uu.x) * mixed.x, bf_hi(uu.x) * mixed.y); w.y = cvt_pk_bf16(bf_lo(uu.y) * mixed.z, bf_hi(uu.y) * mixed.w);
        *(u32x2*)(mp + 16 * cb) = w;
    }
}

struct SRegs { float k0[17], k1[17], v0[17], v1[17]; };
__device__ __forceinline__ void sattn_load_cache(const float* cache, int g, int rem, int lane, int wid, SRegs& R) {
    const int db = rem >> 4, hh = (rem >> 2) & 3, t = rem & 3;
    const int sh = 2 * g, dil = 1 << sh, L = 128 << sh;
    const size_t hoff = (size_t)hh * 128 + 2 * lane;
#pragma unroll
    for (int k = 0; k < 17; ++k) {
        const int s = wid + 8 * k, idx = L + t - s * dil; R.k0[k] = 0.f; R.k1[k] = 0.f; R.v0[k] = 0.f; R.v1[k] = 0.f;
        if (s <= 128 && idx < L) { const float* cp = cache + ((size_t)(db * 2 + 0) * L + idx) * 512 + hoff; const f32x2 kk = __builtin_nontemporal_load((const f32x2*)cp), vv = __builtin_nontemporal_load((const f32x2*)(cp + (size_t)L * 512));
            R.k0[k] = kk.x; R.k1[k] = kk.y; R.v0[k] = vv.x; R.v1[k] = vv.y; }
    }
}
__device__ __forceinline__ void sattn_load_new(const bf16_t* Z, int g, int rem, int lane, int wid, SRegs& R) {
    const int db = rem >> 4, hh = (rem >> 2) & 3, t = rem & 3;
    const int sh = 2 * g, dil = 1 << sh, L = 128 << sh;
    const size_t hoff = (size_t)hh * 128 + 2 * lane;
#pragma unroll
    for (int k = 0; k < 1; ++k) {
        const int s = wid + 8 * k, idx = L + t - s * dil;
        if (s <= 128 && idx >= L) { const bf16_t* zp = Z + (size_t)(MP + db * 4 + (idx - L)) * DIN + g * 512 + hoff; const unsigned kk = *(const unsigned*)(zp + ZK), vv = *(const unsigned*)(zp + ZV);
            R.k0[k] = bf_lo(kk); R.k1[k] = bf_hi(kk); R.v0[k] = bf_lo(vv); R.v1[k] = bf_hi(vv); }
    }
}
__device__ __forceinline__ void sattn_compute(LAS unsigned char* xl, const bf16_t* Z, const float* relb, bf16_t* OG, float* LSE, int g, int rem, int tid, int lane, int wid, const SRegs& R) {
    const int db = rem >> 4, hh = (rem >> 2) & 3, t = rem & 3;
    const int sh = 2 * g, dil = 1 << sh;
    LAS float* bl = (LAS float*)(xl + 6144);
    LAS float* red = (LAS float*)(xl + 1024);
    LAS float* ml = (LAS float*)(xl + 1024 + 4096);
    if (tid < 129) bl[tid] = relb[t5_bucket(tid * dil) * 12 + g * 4 + hh] * LOG2E;
    const int qrow = MP + db * 4 + t;
    const unsigned qq = *(const unsigned*)(Z + (size_t)qrow * DIN + g * 512 + hh * 128 + 2 * lane);
    const float (&k0)[17] = R.k0; const float (&k1)[17] = R.k1; const float (&v0)[17] = R.v0; const float (&v1)[17] = R.v1;
    const float q0 = bf_lo(qq), q1 = bf_hi(qq);
    __syncthreads();
    float pp[17];
#pragma unroll
    for (int k = 0; k < 17; ++k) pp[k] = q0 * k0[k] + q1 * k1[k];
#pragma unroll
    for (int o = 1; o < 64; o <<= 1) {
#pragma unroll
        for (int k = 0; k < 17; ++k) pp[k] += __shfl_xor(pp[k], o);
    }
    float mys = -INFINITY;
#pragma unroll
    for (int k = 0; k < 17; ++k) {
        const int s = wid + 8 * k;
        const float sk = (s <= 128) ? pp[k] + bl[s <= 128 ? s : 0] : -INFINITY;
        mys = (lane == k) ? sk : mys;
    }
    const float mw = wave_max(mys);
    const float p = __builtin_amdgcn_exp2f(mys - mw);
    const float lw = wave_sum(p);
    float o0 = 0.f, o1 = 0.f;
#pragma unroll
    for (int k = 0; k < 17; ++k) { const float pk = __uint_as_float(__builtin_amdgcn_readlane(__float_as_uint(p), k)); o0 += pk * v0[k]; o1 += pk * v1[k]; }
    red[wid * 128 + 2 * lane] = o0; red[wid * 128 + 2 * lane + 1] = o1;
    if (lane == 0) { ml[wid] = mw; ml[8 + wid] = lw; }
    __syncthreads();
    if (tid < 128) {
        float M = ml[0];
#pragma unroll
        for (int w = 1; w < 8; ++w) M = fmaxf(M, ml[w]);
        float Ls = 0.f, o = 0.f;
#pragma unroll
        for (int w = 0; w < 8; ++w) { const float f = __builtin_amdgcn_exp2f(ml[w] - M); Ls += ml[8 + w] * f; o += red[w * 128 + tid] * f; }
        o = o / Ls;
        const float on = __shfl_down(o, 1);
        if ((tid & 1) == 0) *(unsigned*)(OG + ((size_t)g * MPAD + qrow) * 512 + hh * 128 + tid) = cvt_pk_bf16(o, on);
        if (tid == 0) LSE[((size_t)g * MPAD + qrow) * 4 + hh] = M + log2f(Ls);
    }
    __syncthreads();
}

__device__ __forceinline__ void sgate_item(const bf16_t* Z, const float* ssqg, const float* gw, const float* gb, const float* vn, bf16_t* MIX, float* out, int tid) {
    const int db = tid >> 6, c0 = 8 * (tid & 63), grp = c0 >> 7;
    const f32x4 ga = *(const f32x4*)(vn + c0), gb4 = *(const f32x4*)(vn + c0 + 4);
    const float gain[8] = {ga.x, ga.y, ga.z, ga.w, gb4.x, gb4.y, gb4.z, gb4.w};
    float gn[4][8];
#pragma unroll
    for (int s = 0; s < 4; ++s) {
        const int row = MP + db * 4 + s;
        const float rinv = __builtin_amdgcn_rsqf((ssqg[(size_t)row * 2] + ssqg[(size_t)row * 2 + 1]) * (1.0f / 512.0f) + EPS);
        const u32x4 gg = *(const u32x4*)(Z + (size_t)row * DIN + ZG + c0);
#pragma unroll
        for (int j = 0; j < 4; ++j) { gn[s][2 * j] = bf_lo(gg[j]) * rinv * gain[2 * j]; gn[s][2 * j + 1] = bf_hi(gg[j]) * rinv * gain[2 * j + 1]; }
        float* op = out + OUT_GV + (size_t)(db * 4 + s) * 512 + c0;
        *(f32x4*)op = (f32x4){gn[s][0], gn[s][1], gn[s][2], gn[s][3]}; *(f32x4*)(op + 4) = (f32x4){gn[s][4], gn[s][5], gn[s][6], gn[s][7]};
    }
#pragma unroll
    for (int t = 0; t < 4; ++t) {
        const int row = MP + db * 4 + t;
        const u32x4 uu = *(const u32x4*)(Z + (size_t)row * DIN + ZU + c0);
        const float bt = gb[grp * 128 + t];
        float mixed[8];
#pragma unroll
        for (int e = 0; e < 8; ++e) mixed[e] = bt;
#pragma unroll
        for (int s = 0; s < 4; ++s) if (s <= t) { const float w = gw[((size_t)grp * 128 + t) * 128 + s];
#pragma unroll
            for (int e = 0; e < 8; ++e) mixed[e] += w * gn[s][e]; }
        u32x4 w;
#pragma unroll
        for (int j = 0; j < 4; ++j) w[j] = cvt_pk_bf16(bf_lo(uu[j]) * mixed[2 * j], bf_hi(uu[j]) * mixed[2 * j + 1]);
        *(u32x4*)(MIX + (size_t)row * DMIX + 512 + c0) = w;
    }
}

template <class F>
__device__ __forceinline__ void skinny_gemm(LAS unsigned char* lds, const bf16_t* A, const bf16_t* Bt, int K, int N, int KP, int vcu, int G, int tid, int lane, int wid, const F& f) {
    LAS float* red = (LAS float*)lds;
    const int n = lane & 15, fq = lane >> 4, nblk = N / 32, nitems = nblk * KP, kpart = K / KP, kw = kpart / 8;
    for (int it = vcu; it < nitems; it += G) {
        const int ib = it % nblk, kp = it / nblk, n0 = 32 * ib, kb = kp * kpart + wid * kw;
        f32x4 a00 = (f32x4){0.f, 0.f, 0.f, 0.f}, a01 = a00, a10 = a00, a11 = a00;
        const bf16_t* wp = Bt + (size_t)(n0 + n) * K + kb + 8 * fq;
        const bf16_t* ap = A + (size_t)n * K + kb + 8 * fq;
#pragma unroll 4
        for (int k = 0; k < kw; k += 32) {
            const bf16x8 w0 = *(const bf16x8*)(wp + k), w1 = *(const bf16x8*)(wp + (size_t)16 * K + k), x0 = *(const bf16x8*)(ap + k), x1 = *(const bf16x8*)(ap + (size_t)16 * K + k);
            a00 = __builtin_amdgcn_mfma_f32_16x16x32_bf16(w0, x0, a00, 0, 0, 0);
            a01 = __builtin_amdgcn_mfma_f32_16x16x32_bf16(w0, x1, a01, 0, 0, 0);
            a10 = __builtin_amdgcn_mfma_f32_16x16x32_bf16(w1, x0, a10, 0, 0, 0);
            a11 = __builtin_amdgcn_mfma_f32_16x16x32_bf16(w1, x1, a11, 0, 0, 0);
        }
        *(LAS f32x4*)(red + (((wid * 2 + 0) * 2 + 0) * 16 + n) * 16 + 4 * fq) = a00;
        *(LAS f32x4*)(red + (((wid * 2 + 0) * 2 + 1) * 16 + n) * 16 + 4 * fq) = a01;
        *(LAS f32x4*)(red + (((wid * 2 + 1) * 2 + 0) * 16 + n) * 16 + 4 * fq) = a10;
        *(LAS f32x4*)(red + (((wid * 2 + 1) * 2 + 1) * 16 + n) * 16 + 4 * fq) = a11;
        __syncthreads();
#pragma unroll
        for (int j = 0; j < 2; ++j) {
            const int o = tid + 512 * j, row = o >> 5, col = o & 31;
            float v = 0.f;
#pragma unroll
            for (int w = 0; w < 8; ++w) v += red[(((w * 2 + (col >> 4)) * 2 + (row >> 4)) * 16 + (row & 15)) * 16 + (col & 15)];
            f(row, n0 + col, v, ib, kp);
        }
        __syncthreads();
    }
}

constexpr int NPH = 7;
__global__ void __launch_bounds__(512, 2) hymba_fwd(Args args) {
    extern __shared__ __attribute__((aligned(16))) unsigned char lds_raw[];
    LAS unsigned char* lds = (LAS unsigned char*)lds_raw;
    LAS unsigned char* xl = lds + XL_OFF;
    volatile LAS unsigned* MISC = (volatile LAS unsigned*)(lds + MISC_OFF);
    const int tid = threadIdx.x, lane = tid & 63, wid = __builtin_amdgcn_readfirstlane(tid >> 6);
    const int G = gridDim.x, bx = blockIdx.x, vcu = (G % 8 == 0) ? (bx % 8) * (G / 8) + bx / 8 : bx;
    unsigned char* ws = args.ws;
    unsigned* ctl = (unsigned*)(ws + WS_CTL);
    const float* x_p = args.in[0]; const float* x_s = args.in[1]; const float* c128 = args.in[2]; const float* c512 = args.in[3]; const float* c2048 = args.in[4];
    const float* norm_mix = args.in[5]; const float* w_in = args.in[6]; const float* q_norm = args.in[7]; const float* k_norm = args.in[8]; const float* rel_bias = args.in[9];
    const float* v_norm = args.in[10]; const float* gmlp_w = args.in[11]; const float* gmlp_b = args.in[12]; const float* w_out = args.in[13]; const float* norm_ffn = args.in[14];
    const float* w_up = args.in[15]; const float* w_down = args.in[16];
    float* out = args.out;
    bf16_t* WinT = (bf16_t*)(ws + WS_WIN); bf16_t* WoutT = (bf16_t*)(ws + WS_WOUT); bf16_t* WupT = (bf16_t*)(ws + WS_WUP); bf16_t* WdnT = (bf16_t*)(ws + WS_WDN);
    bf16_t* H = (bf16_t*)(ws + WS_H); bf16_t* Z = (bf16_t*)(ws + WS_Z); bf16_t* OG = (bf16_t*)(ws + WS_OG); bf16_t* MIX = (bf16_t*)(ws + WS_MIX); bf16_t* ACT = (bf16_t*)(ws + WS_ACT);
    float* SSQG = (float*)(ws + WS_SSQG); float* LSE = (float*)(ws + WS_LSE); float* SSQ2 = (float*)(ws + WS_SSQ2); float* SSQ2S = (float*)(ws + WS_SSQ2S);

    const P0Weights WP{w_in, w_out, w_up, w_down, norm_ffn, WinT, WoutT, WupT, WdnT};
    for (int u = tid; u < 32; u += 512) MISC[u] = 0u;
    __syncthreads();
    XcdBarrier bar; bar.bar = ctl + CW_BAR + args.li * XCD_BAR_WORDS; bar.x = 0; bar.st = nullptr;
    if (MK_N_LAUNCHES == 1) bar = xcd_barrier_post(ctl + CW_BAR + args.li * XCD_BAR_WORDS, MISC + 8);
#define STAMP(i) do { if (PROBE_T >= 0 && bx == PROBE_T_BX && tid == 0) MISC[16 + (i)] = (unsigned)__builtin_amdgcn_s_memrealtime(); } while (0)
    const int lo = args.ph_lo, hi = args.ph_hi;
#define IN(k) (lo <= (k) && (k) < hi)
#ifndef PROBE_DBLBAR
#define PROBE_DBLBAR 0
#endif
#define SEAM(k) do { if (IN(k) && IN((k) + 1)) { STAMP(2 * (k) + 1); xcd_barrier(bar); if (PROBE_DBLBAR) { xcd_barrier(bar); xcd_barrier(bar); } STAMP(2 * (k) + 2); } } while (0)
    const int gw = vcu * 8 + wid, NGW = G * 8;

    STAMP(0);
    if (IN(0)) {
        LAS float* scr = (LAS float*)(lds + wid * 16384);
        f32x4 wreg[8];
        if (gw < P0_I_IN) { const P0Item q0 = p0_sel(WP, gw); p0_load(q0, wreg, lane); }
        for (int it = gw; it < P0_I_IN; it += NGW) {
            const P0Item q = p0_sel(WP, it);
            p0_to_lds(q, wreg, scr, lane);
            if (it + NGW < P0_I_IN) { const P0Item qn = p0_sel(WP, it + NGW); p0_load(qn, wreg, lane); }
            p0_from_lds(q, scr, lane);
        }
        for (int row = gw; row < MPAD; row += NGW) {
            u32x2* hp = (u32x2*)(H + (size_t)row * DM);
            if (row < MV) {
                const f32x4* xr = (const f32x4*)(row < MP ? x_p + (size_t)row * DM : x_s + (size_t)(row - MP) * DM);
                f32x4 v[8]; float s = 0.f;
#pragma unroll
                for (int j = 0; j < 8; ++j) { v[j] = __builtin_nontemporal_load(xr + lane + 64 * j); s += dot4(v[j]); }
                const float rinv = __builtin_amdgcn_rsqf(wave_sum(s) * (1.0f / DM) + EPS);
#pragma unroll
                for (int j = 0; j < 8; ++j) { const f32x4 gn = ((const f32x4*)norm_mix)[lane + 64 * j]; const f32x4 o = v[j] * rinv * gn;
                    u32x2 w; w.x = cvt_pk_bf16(o.x, o.y); w.y = cvt_pk_bf16(o.z, o.w); hp[lane + 64 * j] = w; }
            } else {
#pragma unroll
                for (int j = 0; j < 8; ++j) hp[lane + 64 * j] = (u32x2){0u, 0u};
            }
        }
    }
    SEAM(0);
    SRegs RA, RB; bool spre = false;
    const int sit0 = vcu, sit1 = vcu + G;
    if (IN(1)) {
        pg8::Gemm g{H, WinT, MPAD, DIN, DM}; pg8::StaticOrder S; S.init(MPAD, DIN, G, bx);
        pg8::EpiZ E{Z, out, q_norm, k_norm, SSQG};
        pg8::gemm_phase<pg8::EpiZ, pg8::StaticOrder, true, true>(lds, xl, g, S, E);
        __syncthreads();
        {
            LAS float* scr = (LAS float*)(lds + wid * 16384);
            const int nunits = (MPAD / 256) * (DIN / 256), n3 = nunits - 2 * G;
            const int nidle = (n3 > 0 && n3 < G) ? G - n3 : 0;
            constexpr int NDEF = P0_NITEMS - P0_I_IN, TAIL_A = 13;
            const int nearly = nidle * 8 * TAIL_A < NDEF ? nidle * 8 * TAIL_A : 0;
            f32x4 wreg[8];
            for (int pass = 0; pass < 2; ++pass) {
                int first, stride, end;
                if (pass == 0) { if (nearly == 0 || bx < n3) continue; first = ((bx - n3) * 8 + wid); stride = nidle * 8; end = nearly; }
                else { first = nearly + gw; stride = NGW; end = NDEF; }
                if (first < end) { const P0Item q0 = p0_sel(WP, P0_I_IN + first); p0_load(q0, wreg, lane); }
                for (int it = first; it < end; it += stride) {
                    const P0Item q = p0_sel(WP, P0_I_IN + it);
                    p0_to_lds(q, wreg, scr, lane);
                    if (it + stride < end) { const P0Item qn = p0_sel(WP, P0_I_IN + it + stride); p0_load(qn, wreg, lane); }
                    p0_from_lds(q, scr, lane);
                }
            }
        }
    }
    if (IN(1) && IN(2)) {
        STAMP(3);
        xcd_barrier_drain();
        if (G >= 192) {
            if (wid != 0) {
                if (sit0 < 384) { const int g = sit0 >> 7; sattn_load_cache(g == 0 ? c128 : (g == 1 ? c512 : c2048), g, sit0 & 127, lane, wid, RA); }
                if (sit1 < 384) { const int g = sit1 >> 7; sattn_load_cache(g == 0 ? c128 : (g == 1 ? c512 : c2048), g, sit1 & 127, lane, wid, RB); }
            }
            spre = true;
        }
        xcd_barrier_sync(bar);
        STAMP(4);
    }
    if (IN(2)) {
        const int skip = args.pad;
        if (!(skip & 4)) {
            if (spre) {
                if (wid == 0) {
                    if (sit0 < 384) { const int g = sit0 >> 7; sattn_load_cache(g == 0 ? c128 : (g == 1 ? c512 : c2048), g, sit0 & 127, lane, wid, RA); }
                    if (sit1 < 384) { const int g = sit1 >> 7; sattn_load_cache(g == 0 ? c128 : (g == 1 ? c512 : c2048), g, sit1 & 127, lane, wid, RB); }
                }
                if (sit0 < 384) sattn_load_new(Z, sit0 >> 7, sit0 & 127, lane, wid, RA);
                if (sit1 < 384) sattn_load_new(Z, sit1 >> 7, sit1 & 127, lane, wid, RB);
                if (sit0 < 384) sattn_compute(xl, Z, rel_bias, OG, LSE, sit0 >> 7, sit0 & 127, tid, lane, wid, RA);
                if (sit1 < 384) sattn_compute(xl, Z, rel_bias, OG, LSE, sit1 >> 7, sit1 & 127, tid, lane, wid, RB);
            } else for (int it = vcu; it < 384; it += G) {
                const int g = it >> 7;
                sattn_load_cache(g == 0 ? c128 : (g == 1 ? c512 : c2048), g, it & 127, lane, wid, RA);
                sattn_load_new(Z, g, it & 127, lane, wid, RA);
                sattn_compute(xl, Z, rel_bias, OG, LSE, g, it & 127, tid, lane, wid, RA);
            }
        }
        if (!(skip & 1)) for (int it = vcu * 3; it < 768; it += 3 * G)
            for (int i = 0; i < 3; ++i) {
                u32x4 kreg[8], vreg[8]; bf16x8 qf[4];
                const AttnDesc d = attn_decode(Z, it + i);
                if (!(skip & 16)) attn_load(d, kreg, vreg, qf, tid, lane, wid);
                else {
#pragma unroll
                    for (int q = 0; q < 8; ++q) { kreg[q] = (u32x4){0x3f803f80u, 0x3f803f80u, 0x3f803f80u, 0x3f803f80u}; vreg[q] = kreg[q]; }
#pragma unroll
                    for (int q = 0; q < 4; ++q) qf[q] = __builtin_bit_cast(bf16x8, kreg[0]);
                }
                if (!(skip & 64)) attn_stage(d, kreg, vreg, lds, xl, rel_bias, tid);
                __syncthreads();
                if (!(skip & 32)) attn_compute(d, qf, lds, xl, OG, LSE, lane, wid);
                __syncthreads();
            }
        if (!(skip & 2)) for (int it = vcu; it < 256; it += G) {
            u32x4 greg[4];
            gate_load(Z, it, greg, tid);
            gate_stage(it, greg, lds, xl, SSQG, tid);
            __syncthreads();
            gate_compute(it, lds, xl, Z, gmlp_w, gmlp_b, v_norm, MIX, lane, wid);
            __syncthreads();
        }
        if (!(skip & 8) && vcu == G - 1) sgate_item(Z, SSQG, gmlp_w, gmlp_b, v_norm, MIX, out, tid);
    }
    SEAM(2);
    if (IN(3)) {
        for (int row = gw; row < MV; row += NGW) {
            const int hh = lane >> 4;
            const float l0 = LSE[((size_t)0 * MPAD + row) * 4 + hh], l1 = LSE[((size_t)1 * MPAD + row) * 4 + hh], l2 = LSE[((size_t)2 * MPAD + row) * 4 + hh];
            const float M = fmaxf(l0, fmaxf(l1, l2));
            float a0 = __builtin_amdgcn_exp2f(l0 - M), a1 = __builtin_amdgcn_exp2f(l1 - M), a2 = __builtin_amdgcn_exp2f(l2 - M);
            const float inv = 1.0f / (a0 + a1 + a2); a0 *= inv; a1 *= inv; a2 *= inv;
            const u32x4 o0 = *(const u32x4*)(OG + ((size_t)0 * MPAD + row) * 512 + 8 * lane), o1 = *(const u32x4*)(OG + ((size_t)1 * MPAD + row) * 512 + 8 * lane), o2 = *(const u32x4*)(OG + ((size_t)2 * MPAD + row) * 512 + 8 * lane);
            u32x4 w;
#pragma unroll
            for (int j = 0; j < 4; ++j) {
                const float lo_ = a0 * bf_lo(o0[j]) + a1 * bf_lo(o1[j]) + a2 * bf_lo(o2[j]);
                const float hi_ = a0 * bf_hi(o0[j]) + a1 * bf_hi(o1[j]) + a2 * bf_hi(o2[j]);
                w[j] = cvt_pk_bf16(lo_, hi_);
            }
            *(u32x4*)(MIX + (size_t)row * DMIX + 8 * lane) = w;
        }
    }
    SEAM(3);
    if (IN(4)) {
        pg8::Gemm g{MIX, WoutT, MP, DM, DMIX}; pg8::StaticOrder S; S.init(MP, DM, G, bx);
        pg8::EpiX1 E{x_p, out, H, SSQ2};
        pg8::gemm_phase<pg8::EpiX1, pg8::StaticOrder, false, true>(lds, xl, g, S, E);
        __syncthreads();
        skinny_gemm(lds, MIX + (size_t)MP * DMIX, WoutT, DMIX, DM, 1, vcu, G, tid, lane, wid, [=](int row, int col, float v, int ib, int) {
            const float x1 = x_s[(size_t)row * DM + col] + v;
            out[OUT_Y + (size_t)(MP + row) * DM + col] = x1;
            H[(size_t)(MP + row) * DM + col] = (bf16_t)(cvt_pk_bf16(x1, 0.f) & 0xffffu);
            float s = x1 * x1;
            s += __shfl_xor(s, 1); s += __shfl_xor(s, 2); s += __shfl_xor(s, 4); s += __shfl_xor(s, 8); s += __shfl_xor(s, 16);
            if ((col & 31) == 0) SSQ2S[row * 64 + ib] = s;
        });
    }
    SEAM(4);
    if (IN(5)) {
        pg8::Gemm g{H, WupT, MP, DFF, DM}; pg8::StaticOrder S; S.init(MP, DFF, G, bx);
        pg8::EpiAct E{ACT, SSQ2};
        pg8::gemm_phase<pg8::EpiAct, pg8::StaticOrder, true, true>(lds, xl, g, S, E);
        __syncthreads();
        LAS float* rs = (LAS float*)xl;
        {
            const int row = tid >> 4, part = tid & 15; float s = 0.f;
#pragma unroll
            for (int j = 0; j < 4; ++j) s += SSQ2S[row * 64 + part * 4 + j];
            s += __shfl_xor(s, 1); s += __shfl_xor(s, 2); s += __shfl_xor(s, 4); s += __shfl_xor(s, 8);
            if (part == 0) rs[row] = __builtin_amdgcn_rsqf(s * (1.0f / DM) + EPS);
        }
        __syncthreads();
        skinny_gemm(lds, H + (size_t)MP * DM, WupT, DM, DFF, 1, vcu, G, tid, lane, wid, [=](int row, int col, float v, int, int) {
            float a = fmaxf(v * rs[row], 0.f); a = a * a;
            ACT[(size_t)(MP + row) * DFF + col] = (bf16_t)(cvt_pk_bf16(a, 0.f) & 0xffffu);
        });
    }
    SEAM(5);
    if (IN(6)) {
        pg8::Gemm g{ACT, WdnT, MP, DM, DFF}; pg8::StaticOrder S; S.init(MP, DM, G, bx);
        pg8::EpiY E{out, H};
        pg8::gemm_phase<pg8::EpiY, pg8::StaticOrder, true, true>(lds, xl, g, S, E);
        __syncthreads();
        skinny_gemm(lds, ACT + (size_t)MP * DFF, WdnT, DFF, DM, 4, vcu, G, tid, lane, wid, [=](int row, int col, float v, int, int) {
            atomicAdd(out + OUT_Y + (size_t)(MP + row) * DM + col, v);
        });
    }
    if (PROBE_T >= 0 && bx == PROBE_T_BX && tid == 0) {
        MISC[16 + 13] = (unsigned)__builtin_amdgcn_s_memrealtime();
        const int a = PROBE_T < 7 ? 2 * PROBE_T : 2 * (PROBE_T - 7) + 1;
        const int b = PROBE_T < 6 ? 2 * PROBE_T + 2 : (PROBE_T == 6 ? 13 : 2 * (PROBE_T - 7) + 2);
        const unsigned d = MISC[16 + b] - MISC[16 + a];
        const unsigned long long t0 = __builtin_amdgcn_s_memrealtime();
        while (__builtin_amdgcn_s_memrealtime() - t0 < (unsigned long long)d * PROBE_T_AMP) __builtin_amdgcn_s_sleep(16);
    }
#undef IN
#undef SEAM
}

extern "C" void kernel_launch(void* const* d_in, const int* in_sizes, int n_in, void* d_out, int out_size, void* d_ws, size_t ws_size, hipStream_t stream) {
    static int grid = 0;
    if (grid == 0) {
        if (n_in != 17 || in_sizes[0] != MP * DM || out_size != (int)OUT_END || ws_size < WS_END) {
            fprintf(stderr, "kernel_launch: unexpected shapes: n_in %d in0 %d out %d ws %zu (need %zu); nothing launched\n", n_in, n_in > 0 ? in_sizes[0] : -1, out_size, ws_size, (size_t)WS_END); grid = -1; return; }
        int dev = 0, cus = 0, per_cu = 0;
        if (hipGetDevice(&dev) != hipSuccess || hipDeviceGetAttribute(&cus, hipDeviceAttributeMultiprocessorCount, dev) != hipSuccess) { fprintf(stderr, "kernel_launch: device query failed\n"); grid = -1; return; }
        if (hipFuncSetAttribute((const void*)hymba_fwd, hipFuncAttributeMaxDynamicSharedMemorySize, LDS_BYTES) != hipSuccess) { fprintf(stderr, "kernel_launch: hipFuncSetAttribute failed\n"); grid = -1; return; }
        if (hipOccupancyMaxActiveBlocksPerMultiprocessor(&per_cu, (const void*)hymba_fwd, 512, LDS_BYTES) != hipSuccess || per_cu < 1)
            fprintf(stderr, "kernel_launch: note: occupancy query reports %d workgroups per CU\n", per_cu);
        (void)hipGetLastError();
        grid = cus;
        if (cus < 256) fprintf(stderr, "kernel_launch: built for a 256-CU device (P4 / P6 keep one GEMM unit per workgroup); %d CUs reported\n", cus);
    }
    if (grid < 0) return;
    if (hipMemsetAsync((char*)d_ws + WS_CTL, 0, CTL_ZERO_BYTES, stream) != hipSuccess) { fprintf(stderr, "kernel_launch: memset failed\n"); return; }
    Args a{};
    for (int i = 0; i < 17; ++i) a.in[i] = (const float*)d_in[i];
    a.out = (float*)d_out; a.ws = (unsigned char*)d_ws;
    if (PROBE_LO >= 0) {
        const int lo3[3] = {0, PROBE_LO, PROBE_HI}, hi3[3] = {PROBE_HI, PROBE_HI, NPH};
        for (int li = 0; li < 3; ++li) { a.ph_lo = lo3[li]; a.ph_hi = hi3[li]; a.li = li; a.pad = (li == 1) ? PROBE_SKIP : 0; if (a.ph_lo < a.ph_hi) hipLaunchKernelGGL(hymba_fwd, dim3(grid), dim3(512), LDS_BYTES, stream, a); }
        return;
    }
    for (int li = 0; li < MK_N_LAUNCHES; ++li) {
        if (MK_N_LAUNCHES == 1) { a.ph_lo = 0; a.ph_hi = NPH; } else { a.ph_lo = li; a.ph_hi = li + 1; }
        a.li = 0;
        hipLaunchKernelGGL(hymba_fwd, dim3(grid), dim3(512), LDS_BYTES, stream, a);
        const hipError_t le = hipPeekAtLastError();
        if (le != hipSuccess) { fprintf(stderr, "kernel_launch: launch %d failed: %s\n", li, hipGetErrorName(le)); break; }
    }
}
```

```cpp
#include <hip/hip_runtime.h>
#include <cstdio>
#include <cstdint>

#ifndef CODE_PAD
#define CODE_PAD 5
#endif
#ifndef CODE_PAD1
#define CODE_PAD1 1
#endif
#ifndef MK_N_LAUNCHES
#define MK_N_LAUNCHES 1
#endif
#ifndef PROBE_LO
#define PROBE_LO -1
#define PROBE_HI -1
#endif
#ifndef PROBE_T
#define PROBE_T -1
#define PROBE_T_BX 0
#define PROBE_T_AMP 4
#endif
#ifndef PROBE_SKIP
#define PROBE_SKIP 0
#endif

constexpr int DM = 2048, SEQ = 4096, NB = 2, MP = NB * SEQ  , MS = 32  , MV = MP + MS  , MPAD = 8448  ;
constexpr int DIN = 5632, DMIX = 1024, DFF = 8192;
constexpr int ZQ = 0, ZK = 1536, ZV = 3072, ZU = 4608, ZG = 5120;
constexpr float EPS = 1e-6f;
constexpr float LOG2E = 1.4426950408889634f;
constexpr float QSCALE = 0.08838834764831845f * 1.4426950408889634f;
constexpr size_t OUT_Y = 0;
constexpr size_t OUT_KVP0 = (size_t)MV * DM;
constexpr size_t OUT_KVP1 = OUT_KVP0 + 2 * 2 * 128 * 512;
constexpr size_t OUT_KVP2 = OUT_KVP1 + 2 * 2 * 512 * 512;
constexpr size_t OUT_KVS0 = OUT_KVP2 + 2 * 2 * 2048 * 512;
constexpr size_t OUT_GV = OUT_KVS0 + 3 * 32768;
constexpr size_t OUT_END = OUT_GV + 16384;
static_assert(OUT_END == 22462464, "d_out map");

constexpr size_t MiB = 1u << 20;
constexpr size_t WS_CTL = 0, CTL_ZERO_BYTES = 64 * 1024;
constexpr size_t WS_SSQG = 1 * MiB;
constexpr size_t WS_LSE = WS_SSQG + (size_t)MPAD * 2 * 4;
constexpr size_t WS_SSQ2 = WS_LSE + (size_t)3 * MPAD * 4 * 4;
constexpr size_t WS_SSQ2S = WS_SSQ2 + (size_t)MPAD * 8 * 4;
static_assert(WS_SSQ2S + 32 * 128 * 4 <= 2 * MiB, "small arrays");
constexpr size_t WS_WIN = 2 * MiB, WS_WOUT = 24 * MiB, WS_WUP = 28 * MiB, WS_WDN = 60 * MiB;
constexpr size_t WS_H = 92 * MiB;
constexpr size_t WS_ACT = 125 * MiB;
constexpr size_t WS_Z = WS_ACT;
constexpr size_t WS_OG = WS_Z + (size_t)MPAD * DIN * 2;
constexpr size_t WS_MIX = WS_OG + (size_t)3 * MPAD * 512 * 2;
constexpr size_t WS_END = WS_ACT + (size_t)MPAD * DFF * 2;
static_assert(WS_MIX + (size_t)MPAD * DMIX * 2 <= WS_END && WS_H + (size_t)MPAD * DM * 2 <= WS_ACT && WS_WDN + (size_t)DM * DFF * 2 <= WS_H && WS_WIN + (size_t)DIN * DM * 2 <= WS_WOUT, "d_ws map");
constexpr int CW_BAR = 4096, CW_QUEUE = 2048, CW_SKINNY = 2048 + 1024;

constexpr int RING_BYTES = 131072;
constexpr int XL_OFF = RING_BYTES;
constexpr int XL_BYTES = 12288;
constexpr int MISC_OFF = XL_OFF + XL_BYTES;
constexpr int LDS_BYTES = 147456;
static_assert(MISC_OFF + 128 <= LDS_BYTES, "LDS map");

#define GAS __attribute__((address_space(1)))
#define LAS __attribute__((address_space(3)))
typedef unsigned short bf16_t;
typedef short bf16x8 __attribute__((ext_vector_type(8)));
typedef short s16x4 __attribute__((ext_vector_type(4)));
typedef float f32x4 __attribute__((ext_vector_type(4)));
typedef float f32x2 __attribute__((ext_vector_type(2)));
typedef unsigned u32x4 __attribute__((ext_vector_type(4)));
typedef unsigned u32x2 __attribute__((ext_vector_type(2)));

__device__ __forceinline__ unsigned cvt_pk_bf16(float lo, float hi) { unsigned r; asm volatile("v_cvt_pk_bf16_f32 %0, %1, %2" : "=v"(r) : "v"(lo), "v"(hi)); return r; }
__device__ __forceinline__ float bf_lo(unsigned w) { return __uint_as_float(w << 16); }
__device__ __forceinline__ float bf_hi(unsigned w) { return __uint_as_float(w & 0xffff0000u); }
__device__ __forceinline__ float dot4(f32x4 a) { return (a.x * a.x + a.y * a.y) + (a.z * a.z + a.w * a.w); }
template <int CTRL> __device__ __forceinline__ float dpp_f(float v) { return __int_as_float(__builtin_amdgcn_update_dpp(__float_as_int(v), __float_as_int(v), CTRL, 0xF, 0xF, true)); }
__device__ __forceinline__ float row_sum16(float v) { v += dpp_f<0xB1>(v); v += dpp_f<0x4E>(v); v += dpp_f<0x141>(v); v += dpp_f<0x140>(v); return v; }
__device__ __forceinline__ float row_max16(float v) { v = fmaxf(v, dpp_f<0xB1>(v)); v = fmaxf(v, dpp_f<0x4E>(v)); v = fmaxf(v, dpp_f<0x141>(v)); v = fmaxf(v, dpp_f<0x140>(v)); return v; }
__device__ __forceinline__ float wave_sum(float v) { v = row_sum16(v); v += __shfl_xor(v, 16); v += __shfl_xor(v, 32); return v; }
__device__ __forceinline__ float wave_max(float v) { v = row_max16(v); v = fmaxf(v, __shfl_xor(v, 16)); v = fmaxf(v, __shfl_xor(v, 32)); return v; }
#define EPI_BAR() do { asm volatile("s_waitcnt lgkmcnt(0)" ::: "memory"); __builtin_amdgcn_s_barrier(); asm volatile("" ::: "memory"); } while (0)

namespace pg8 {
#define PG8_LAS __attribute__((address_space(3)))
constexpr int BM = 256, BK = 64, HALF = 128, HTB = HALF * BK * 2, STAGE_BYTES = 8 * HTB, NXCD = 8, WGM = 8;
__host__ __device__ __forceinline__ int lds_byte(int r, int c) { const int st = (r >> 4) * 2 + (c >> 5), rr = r & 15, cc = c & 31, ob = rr * 64 + cc * 2; return st * 1024 + (ob ^ (((ob >> 9) & 1) << 5)); }
__host__ __device__ __forceinline__ void stage_rc(int b, int& R, int& C) { const int st = b / 1024, sb = b % 1024, swz = sb ^ (((sb >> 9) & 1) << 5); R = (st >> 1) * 16 + swz / 64; C = (st & 1) * 32 + (swz % 64) / 2; }
__host__ __device__ __forceinline__ int perm32(int rho) { const int n = rho >> 4, i = rho & 15; return 8 * (i >> 2) + 4 * n + (i & 3); }

struct Unit { int pm, pn; };
struct Gemm { const bf16_t* A; const bf16_t* Bt; int M, N, K; };

struct StaticOrder {
    int nM, nN, nwg, G, c;
    __host__ __device__ void init(int M, int N, int G_, int c_) { nM = M / BM; nN = N / BM; nwg = nM * nN; G = G_; c = c_; }
    __host__ __device__ bool next(int i, Unit& u) const {
        const long L = (long)i * G + c; if (L >= nwg) return false;
        int wgid = (int)L; { const int q = nwg / NXCD, r = nwg % NXCD, xcd = wgid % NXCD, off = wgid / NXCD; wgid = (xcd < r ? xcd * (q + 1) : r * (q + 1) + (xcd - r) * q) + off; }
        const int nig = WGM * nN, gid = wgid / nig, fm = gid * WGM, gsz = (nM - fm) < WGM ? (nM - fm) : WGM;
        u.pm = fm + ((wgid % nig) % gsz); u.pn = (wgid % nig) / gsz; return true;
    }
    __device__ __forceinline__ void a_ready(const Unit&) const {}
    __device__ __forceinline__ void done(const Unit&) const {}
};

__device__ __forceinline__ f32x2 gelu_pk(f32x2 v) {
    const f32x2 av = __builtin_elementwise_abs(v), d = av * 0.2316418882f + 1.0f;
    f32x2 t; t.x = __builtin_amdgcn_rcpf(d.x); t.y = __builtin_amdgcn_rcpf(d.y);
    f32x2 q = t * 0.5307027145f + (-0.7265760135f); q = q * t + 0.7107068705f; q = q * t + (-0.142248368f); q = q * t + 0.127414796f; q = q * t;
    const f32x2 s = (v * v) * (-0.72134752044f);
    f32x2 e; e.x = __builtin_amdgcn_exp2f(s.x); e.y = __builtin_amdgcn_exp2f(s.y);
    const f32x2 m = v * (q * e), r = v - m;
    f32x2 o; o.x = v.x < 0.f ? m.x : r.x; o.y = v.y < 0.f ? m.y : r.y; return o;
}
__device__ __forceinline__ f32x4 gelu4(f32x4 v) { const f32x2 a = gelu_pk((f32x2){v.x, v.y}), b = gelu_pk((f32x2){v.z, v.w}); return (f32x4){a.x, a.y, b.x, b.y}; }
__device__ __forceinline__ u32x4 pack8(f32x4 v0, f32x4 v1) { u32x4 w; w.x = cvt_pk_bf16(v0.x, v0.y); w.y = cvt_pk_bf16(v0.z, v0.w); w.z = cvt_pk_bf16(v1.x, v1.y); w.w = cvt_pk_bf16(v1.z, v1.w); return w; }

__device__ __forceinline__ float* kv_dst(float* out, int row, int gi, int kv, int hh) {
    if (row < MP) {
        const int keep = 128 << (2 * gi), b = row >> 12, t = row & 4095, pos = t - (SEQ - keep);
        if (pos < 0) return nullptr;
        const size_t base = gi == 0 ? OUT_KVP0 : (gi == 1 ? OUT_KVP1 : OUT_KVP2);
        return out + base + ((size_t)((b * 2 + kv) * keep + pos) * 4 + hh) * 128;
    }
    const int j = row - MP; if (j >= MS) return nullptr;
    return out + OUT_KVS0 + (size_t)gi * 32768 + ((size_t)(((j >> 2) * 2 + kv) * 4 + (j & 3)) * 4 + hh) * 128;
}

struct EpiZ {
    static constexpr bool INIT_ACC = false; struct InitRegs {};
    static constexpr bool PERM = true, AFTER_DRAIN = false;
    bf16_t* Z; float* out; const float* qn; const float* kn; float* ssqg;
    __device__ __forceinline__ void operator()(f32x4 (&acc)[2][2][4][2], const Unit& u, int wr, int wc, int fr, int fq, PG8_LAS unsigned char* xl) const {
        const int pn = u.pn, rowl0 = wr * 64 + fr, cl0 = wc * 32 + 8 * fq;
        PG8_LAS float* P = (PG8_LAS float*)xl;
        if (pn < 12) {
            const bool isq = pn < 6;
            const float* gp = (isq ? qn : kn) + cl0;
            f32x4 g0 = *(const f32x4*)gp, g1 = *(const f32x4*)(gp + 4);
#pragma unroll
            for (int ai = 0; ai < 2; ++ai)
#pragma unroll
                for (int m = 0; m < 4; ++m)
#pragma unroll
                    for (int bj = 0; bj < 2; ++bj) {
                        float s = dot4(acc[ai][bj][m][0]) + dot4(acc[ai][bj][m][1]);
                        s += __shfl_xor(s, 16); s += __shfl_xor(s, 32);
                        if (fq == 0) P[((128 * ai + 16 * m + rowl0) * 2 + bj) * 4 + wc] = s;
                    }
            EPI_BAR();
            if (isq) { g0 = g0 * QSCALE; g1 = g1 * QSCALE; }
            const int cp = isq ? pn : pn - 6, gi = cp >> 1;
#pragma unroll
            for (int ai = 0; ai < 2; ++ai)
#pragma unroll
                for (int m = 0; m < 4; ++m) {
                    const int rowl = 128 * ai + 16 * m + rowl0, row = u.pm * BM + rowl;
#pragma unroll
                    for (int bj = 0; bj < 2; ++bj) {
                        const f32x4 p = *(const PG8_LAS f32x4*)(P + (rowl * 2 + bj) * 4);
                        const float rinv = __builtin_amdgcn_rsqf(((p.x + p.y) + (p.z + p.w)) * (1.0f / 128.0f) + EPS);
                        const f32x4 v0 = acc[ai][bj][m][0] * rinv * g0, v1 = acc[ai][bj][m][1] * rinv * g1;
                        *(u32x4*)(Z + (size_t)row * DIN + pn * BM + bj * HALF + cl0) = pack8(v0, v1);
                        if (!isq) { float* dp = kv_dst(out, row, gi, 0, (cp & 1) * 2 + bj); if (dp) { __builtin_nontemporal_store(v0, (f32x4*)(dp + cl0)); __builtin_nontemporal_store(v1, (f32x4*)(dp + cl0 + 4)); } }
                    }
                }
        } else if (pn < 18) {
            const int cp = pn - 12, gi = cp >> 1;
#pragma unroll
            for (int ai = 0; ai < 2; ++ai)
#pragma unroll
                for (int m = 0; m < 4; ++m) {
                    const int rowl = 128 * ai + 16 * m + rowl0, row = u.pm * BM + rowl;
#pragma unroll
                    for (int bj = 0; bj < 2; ++bj) {
                        const f32x4 v0 = acc[ai][bj][m][0], v1 = acc[ai][bj][m][1];
                        *(u32x4*)(Z + (size_t)row * DIN + pn * BM + bj * HALF + cl0) = pack8(v0, v1);
                        float* dp = kv_dst(out, row, gi, 1, (cp & 1) * 2 + bj); if (dp) { __builtin_nontemporal_store(v0, (f32x4*)(dp + cl0)); __builtin_nontemporal_store(v1, (f32x4*)(dp + cl0 + 4)); }
                    }
                }
        } else {
            const bool isg = pn >= 20;
#pragma unroll
            for (int ai = 0; ai < 2; ++ai)
#pragma unroll
                for (int m = 0; m < 4; ++m) {
                    const int rowl = 128 * ai + 16 * m + rowl0, row = u.pm * BM + rowl;
                    float s = 0.f;
#pragma unroll
                    for (int bj = 0; bj < 2; ++bj) {
                        const f32x4 v0 = gelu4(acc[ai][bj][m][0]), v1 = gelu4(acc[ai][bj][m][1]);
                        s += dot4(v0) + dot4(v1);
                        *(u32x4*)(Z + (size_t)row * DIN + pn * BM + bj * HALF + cl0) = pack8(v0, v1);
                    }
                    if (isg) { s += __shfl_xor(s, 16); s += __shfl_xor(s, 32); if (fq == 0) P[rowl * 4 + wc] = s; }
                }
            if (isg) {
                EPI_BAR();
                const int t = threadIdx.x;
                if (t < 256) { const f32x4 p = *(const PG8_LAS f32x4*)(P + t * 4); ssqg[(size_t)(u.pm * BM + t) * 2 + (pn - 20)] = (p.x + p.y) + (p.z + p.w); }
            }
        }
    }
};
struct EpiX1 {
    static constexpr bool INIT_ACC = false; struct InitRegs {};
    static constexpr bool PERM = false, AFTER_DRAIN = true;
    const float* x; float* out; bf16_t* x1b; float* ssq2;
    __device__ __forceinline__ void fused(f32x4 (&acc)[2][2][4][2], const Unit& u, int wr, int wc, int fr, int fq, PG8_LAS unsigned char* xl) const {
        PG8_LAS float* P = (PG8_LAS float*)xl;
        const int rowl0 = wr * 64 + fr, col0 = u.pn * BM + wc * 32 + 4 * fq;
#pragma unroll
        for (int ai = 0; ai < 2; ++ai) {
            f32x4 xv[4][2][2];
#pragma unroll
            for (int m = 0; m < 4; ++m) { const size_t off = (size_t)(u.pm * BM + 128 * ai + 16 * m + rowl0) * DM + col0;
#pragma unroll
                for (int bj = 0; bj < 2; ++bj)
#pragma unroll
                    for (int n = 0; n < 2; ++n) xv[m][bj][n] = __builtin_nontemporal_load((const f32x4*)(x + off + bj * HALF + n * 16)); }
            asm volatile("" ::: "memory");
#pragma unroll
            for (int m = 0; m < 4; ++m) {
                const int rowl = 128 * ai + 16 * m + rowl0; const size_t off = (size_t)(u.pm * BM + rowl) * DM + col0;
                float s = 0.f;
#pragma unroll
                for (int bj = 0; bj < 2; ++bj)
#pragma unroll
                    for (int n = 0; n < 2; ++n) {
                        const size_t o = off + bj * HALF + n * 16;
                        const f32x4 v = xv[m][bj][n] + acc[ai][bj][m][n];
                        s += dot4(v);
                        u32x2 w; w.x = cvt_pk_bf16(v.x, v.y); w.y = cvt_pk_bf16(v.z, v.w); *(u32x2*)(x1b + o) = w;
                    }
                s += __shfl_xor(s, 16); s += __shfl_xor(s, 32);
                if (fq == 0) P[rowl * 4 + wc] = s;
            }
        }
        EPI_BAR();
        const int t = threadIdx.x;
        if (t < 256) { const f32x4 p = *(const PG8_LAS f32x4*)(P + t * 4); ssq2[(size_t)(u.pm * BM + t) * 8 + u.pn] = (p.x + p.y) + (p.z + p.w); }
    }
};
struct EpiAct {
    static constexpr bool INIT_ACC = false; struct InitRegs {};
    static constexpr bool PERM = true, AFTER_DRAIN = false;
    bf16_t* act; const float* ssq2;
    __device__ __forceinline__ void operator()(f32x4 (&acc)[2][2][4][2], const Unit& u, int wr, int wc, int fr, int fq, PG8_LAS unsigned char*) const {
        const int rowl0 = wr * 64 + fr, cl0 = wc * 32 + 8 * fq;
        float rv[2][4];
        {
            f32x4 sa[2][4], sb[2][4];
#pragma unroll
            for (int ai = 0; ai < 2; ++ai)
#pragma unroll
                for (int m = 0; m < 4; ++m) { const int row = u.pm * BM + 128 * ai + 16 * m + rowl0; sa[ai][m] = *(const f32x4*)(ssq2 + (size_t)row * 8); sb[ai][m] = *(const f32x4*)(ssq2 + (size_t)row * 8 + 4); }
            asm volatile("" ::: "memory");
#pragma unroll
            for (int ai = 0; ai < 2; ++ai)
#pragma unroll
                for (int m = 0; m < 4; ++m) { const f32x4 a = sa[ai][m], b = sb[ai][m]; rv[ai][m] = __builtin_amdgcn_rsqf((((a.x + a.y) + (a.z + a.w)) + ((b.x + b.y) + (b.z + b.w))) * (1.0f / DM) + EPS); }
        }
#pragma unroll
        for (int ai = 0; ai < 2; ++ai)
#pragma unroll
            for (int m = 0; m < 4; ++m) {
                const int row = u.pm * BM + 128 * ai + 16 * m + rowl0;
                const float rinv = rv[ai][m];
#pragma unroll
                for (int bj = 0; bj < 2; ++bj) {
                    f32x4 v0 = acc[ai][bj][m][0] * rinv, v1 = acc[ai][bj][m][1] * rinv;
                    v0 = __builtin_elementwise_max(v0, (f32x4){0.f, 0.f, 0.f, 0.f}); v1 = __builtin_elementwise_max(v1, (f32x4){0.f, 0.f, 0.f, 0.f});
                    *(u32x4*)(act + (size_t)row * DFF + u.pn * BM + bj * HALF + cl0) = pack8(v0 * v0, v1 * v1);
                }
            }
    }
};
struct EpiY {
    static constexpr bool PERM = false, AFTER_DRAIN = true, INIT_ACC = true;
    struct InitRegs { u32x2 xb[2][4][2][2]; };
    float* out; const bf16_t* x1b;
    __device__ __forceinline__ void init_issue(InitRegs& R, const Unit& u, int wr, int wc, int fr, int fq) const {
        const int rowl0 = wr * 64 + fr, col0 = u.pn * BM + wc * 32 + 4 * fq;
#pragma unroll
        for (int ai = 0; ai < 2; ++ai)
#pragma unroll
            for (int m = 0; m < 4; ++m) { const size_t off = (size_t)(u.pm * BM + 128 * ai + 16 * m + rowl0) * DM + col0;
#pragma unroll
                for (int bj = 0; bj < 2; ++bj)
#pragma unroll
                    for (int n = 0; n < 2; ++n) R.xb[ai][m][bj][n] = __builtin_nontemporal_load((const u32x2*)(x1b + off + bj * HALF + n * 16)); }
    }
    __device__ __forceinline__ void init_finish(f32x4 (&acc)[2][2][4][2], const InitRegs& R) const {
#pragma unroll
        for (int ai = 0; ai < 2; ++ai)
#pragma unroll
            for (int m = 0; m < 4; ++m)
#pragma unroll
                for (int bj = 0; bj < 2; ++bj)
#pragma unroll
                    for (int n = 0; n < 2; ++n) { const u32x2 q = R.xb[ai][m][bj][n]; acc[ai][bj][m][n] = (f32x4){bf_lo(q.x), bf_hi(q.x), bf_lo(q.y), bf_hi(q.y)}; }
    }
    __device__ __forceinline__ void fused(f32x4 (&acc)[2][2][4][2], const Unit& u, int wr, int wc, int fr, int fq, PG8_LAS unsigned char*) const {
        const int rowl0 = wr * 64 + fr, col0 = u.pn * BM + wc * 32 + 4 * fq;
#pragma unroll
        for (int ai = 0; ai < 2; ++ai)
#pragma unroll
            for (int m = 0; m < 4; ++m) {
                const size_t off = (size_t)(u.pm * BM + 128 * ai + 16 * m + rowl0) * DM + col0;
#pragma unroll
                for (int bj = 0; bj < 2; ++bj)
#pragma unroll
                    for (int n = 0; n < 2; ++n) *(f32x4*)(out + off + bj * HALF + n * 16) = acc[ai][bj][m][n];
            }
    }
};

template <class Epi, class Sched, bool ALIGN_EPI = false, bool SP2 = false>
__device__ __forceinline__ void gemm_phase(PG8_LAS unsigned char* lds, PG8_LAS unsigned char* xl, const Gemm g, const Sched& S, const Epi& E) {
    const int tid = threadIdx.x, wid = __builtin_amdgcn_readfirstlane(tid >> 6), lane = tid & 63, wr = wid >> 2, wc = wid & 3, fr = lane & 15, fq = lane >> 4;
    const int K = g.K, nt = K / BK;
    unsigned voffA[2], voffB[2];
#pragma unroll
    for (int i = 0; i < 2; ++i) { int R, C; stage_rc(tid * 16 + i * 8192, R, C); const int Rb = Epi::PERM ? ((R & ~31) + perm32(R & 31)) : R;
        voffA[i] = (unsigned)(R * K + C) * 2u; voffB[i] = (unsigned)(Rb * K + C) * 2u; }
    const size_t kstep = (size_t)(BK * 2);
    const size_t hstep = (size_t)HALF * K * 2;
    const size_t tstep = 2 * hstep;
    const unsigned ldsw = (unsigned)wid * 1024u;
    const int aoff = lds_byte(wr * 64 + fr, fq * 8), boff = lds_byte(wc * 32 + fr, fq * 8);
#define PG8_SA(b, h) (((b) * 2 + (h)) * HTB)
#define PG8_SB(b, h) ((4 + (b) * 2 + (h)) * HTB)
#define PG8_STAGE(bufoff, gbase, voff) do { _Pragma("unroll") for (int _i = 0; _i < 2; ++_i) \
        __builtin_amdgcn_global_load_lds((const unsigned*)((const char*)(gbase) + (voff)[_i]), (PG8_LAS unsigned*)(lds + (bufoff) + ldsw + _i * 8192), 16, 0, 0); } while (0)
#define PG8_LDA(dst, b, h) do { _Pragma("unroll") for (int m = 0; m < 4; ++m) _Pragma("unroll") for (int k = 0; k < 2; ++k) dst[m][k] = *(const PG8_LAS bf16x8*)(lds + PG8_SA(b, h) + aoff + m * 2048 + k * 1024); } while (0)
#define PG8_LDB(dst, b, h) do { _Pragma("unroll") for (int n = 0; n < 2; ++n) _Pragma("unroll") for (int k = 0; k < 2; ++k) dst[n][k] = *(const PG8_LAS bf16x8*)(lds + PG8_SB(b, h) + boff + n * 2048 + k * 1024); } while (0)
#define PG8_MMA(ai, bj, At, Bt) do { __builtin_amdgcn_s_setprio(1); _Pragma("unroll") for (int m = 0; m < 4; ++m) _Pragma("unroll") for (int n = 0; n < 2; ++n) _Pragma("unroll") for (int k = 0; k < 2; ++k) \
        acc[ai][bj][m][n] = __builtin_amdgcn_mfma_f32_16x16x32_bf16(Bt[n][k], At[m][k], acc[ai][bj][m][n], 0, 0, 0); __builtin_amdgcn_s_setprio(0); } while (0)
#define PG8_WAIT_V(n) asm volatile("s_waitcnt vmcnt(" #n ")" ::: "memory")
#define PG8_WAIT_L(n) asm volatile("s_waitcnt lgkmcnt(" #n ")" ::: "memory")
#define PG8_BAR __builtin_amdgcn_s_barrier()
#define PG8_SCHED __builtin_amdgcn_sched_barrier(0)
    Unit cur, nxt; int ui = 0;
    if (!S.next(0, cur)) return;
    f32x4 acc[2][2][4][2];
    typename Epi::InitRegs ir;
    if constexpr (Epi::INIT_ACC) E.init_issue(ir, cur, wr, wc, fr, fq);
    else {
#pragma unroll
    for (int a = 0; a < 2; ++a)
#pragma unroll
        for (int b = 0; b < 2; ++b)
#pragma unroll
            for (int m = 0; m < 4; ++m)
#pragma unroll
                for (int n = 0; n < 2; ++n) acc[a][b][m][n] = (f32x4){0.f, 0.f, 0.f, 0.f};
    }
    bf16x8 At[4][2], B0[2][2], B1[2][2];
    const char* cA = (const char*)g.A + (size_t)cur.pm * tstep; const char* cB = (const char*)g.Bt + (size_t)cur.pn * tstep;
    S.a_ready(cur);
    if constexpr (SP2) {
        PG8_STAGE(PG8_SB(0, 0), cB, voffB); PG8_STAGE(PG8_SB(0, 1), cB + hstep, voffB); PG8_STAGE(PG8_SA(0, 0), cA, voffA); PG8_STAGE(PG8_SA(0, 1), cA + hstep, voffA);
        if constexpr (Epi::INIT_ACC) E.init_finish(acc, ir);
        if (wr == 1) PG8_BAR;
        PG8_WAIT_V(2); PG8_BAR;
        PG8_STAGE(PG8_SB(1, 0), cB + kstep, voffB); PG8_STAGE(PG8_SA(1, 0), cA + kstep, voffA); PG8_STAGE(PG8_SB(1, 1), cB + hstep + kstep, voffB);
        PG8_WAIT_V(6); PG8_BAR;
    } else {
        PG8_STAGE(PG8_SB(0, 0), cB, voffB); PG8_STAGE(PG8_SA(0, 0), cA, voffA); PG8_STAGE(PG8_SB(0, 1), cB + hstep, voffB); PG8_STAGE(PG8_SA(0, 1), cA + hstep, voffA);
        if constexpr (Epi::INIT_ACC) E.init_finish(acc, ir);
        if (wr == 1) PG8_BAR;
        PG8_WAIT_V(4); PG8_BAR;
        PG8_STAGE(PG8_SB(1, 0), cB + kstep, voffB); PG8_STAGE(PG8_SA(1, 0), cA + kstep, voffA); PG8_STAGE(PG8_SB(1, 1), cB + hstep + kstep, voffB);
        PG8_WAIT_V(6); PG8_BAR;
    }
    for (;;) {
        const bool has_next = S.next(ui + 1, nxt);
        const char* nA = has_next ? (const char*)g.A + (size_t)nxt.pm * tstep : cA; const char* nB = has_next ? (const char*)g.Bt + (size_t)nxt.pn * tstep : cB;
        for (int t = 0; t < nt; t += 2) {
            const bool last = (t == nt - 2);
            const char* a1 = cA + (size_t)(t + 1) * kstep;
            const char* a2 = last ? nA : cA + (size_t)(t + 2) * kstep; const char* b2 = last ? nB : cB + (size_t)(t + 2) * kstep;
            const char* a3 = a2 + kstep; const char* b3 = b2 + kstep;
            if (last && has_next) S.a_ready(nxt);
            if constexpr (SP2) {
            PG8_LDB(B0, 0, 0); PG8_LDB(B1, 0, 1); PG8_SCHED; PG8_LDA(At, 0, 0); PG8_STAGE(PG8_SA(1, 1), a1 + hstep, voffA);
            PG8_WAIT_V(8); PG8_WAIT_L(0); PG8_BAR; PG8_MMA(0, 0, At, B0); PG8_MMA(0, 1, At, B1); PG8_BAR; PG8_SCHED;
            PG8_LDA(At, 0, 1); PG8_STAGE(PG8_SB(0, 0), b2, voffB); PG8_STAGE(PG8_SB(0, 1), b2 + hstep, voffB); PG8_STAGE(PG8_SA(0, 0), a2, voffA);
            PG8_WAIT_V(8); PG8_WAIT_L(0); PG8_BAR; PG8_MMA(1, 0, At, B0); PG8_MMA(1, 1, At, B1); PG8_BAR; PG8_SCHED;
            PG8_LDB(B0, 1, 0); PG8_LDB(B1, 1, 1); PG8_SCHED; PG8_LDA(At, 1, 0); PG8_STAGE(PG8_SA(0, 1), a2 + hstep, voffA);
            PG8_WAIT_V(8); PG8_WAIT_L(0); PG8_BAR; PG8_MMA(0, 0, At, B0); PG8_MMA(0, 1, At, B1); PG8_BAR; PG8_SCHED;
            PG8_LDA(At, 1, 1); PG8_STAGE(PG8_SB(1, 0), b3, voffB); PG8_STAGE(PG8_SB(1, 1), b3 + hstep, voffB); PG8_STAGE(PG8_SA(1, 0), a3, voffA);
            PG8_WAIT_V(8); PG8_WAIT_L(0); PG8_BAR; PG8_MMA(1, 0, At, B0); PG8_MMA(1, 1, At, B1); PG8_BAR; PG8_SCHED;
            } else {
            PG8_LDB(B0, 0, 0); PG8_SCHED; PG8_LDA(At, 0, 0); PG8_STAGE(PG8_SA(1, 1), a1 + hstep, voffA);
            PG8_WAIT_L(8); PG8_BAR; PG8_WAIT_L(0); PG8_MMA(0, 0, At, B0); PG8_BAR; PG8_SCHED;
            PG8_LDB(B1, 0, 1); PG8_STAGE(PG8_SB(0, 0), b2, voffB);
            PG8_BAR; PG8_WAIT_L(0); PG8_MMA(0, 1, At, B1); PG8_BAR;
            PG8_LDA(At, 0, 1); PG8_STAGE(PG8_SA(0, 0), a2, voffA);
            PG8_BAR; PG8_WAIT_L(0); PG8_MMA(1, 0, At, B0); PG8_BAR; PG8_SCHED;
            PG8_STAGE(PG8_SB(0, 1), b2 + hstep, voffB);
            PG8_WAIT_V(6); PG8_BAR; PG8_MMA(1, 1, At, B1); PG8_BAR;
            PG8_LDB(B0, 1, 0); PG8_SCHED; PG8_LDA(At, 1, 0); PG8_STAGE(PG8_SA(0, 1), a2 + hstep, voffA);
            PG8_WAIT_L(8); PG8_BAR; PG8_WAIT_L(0); PG8_MMA(0, 0, At, B0); PG8_BAR; PG8_SCHED;
            PG8_LDB(B1, 1, 1); PG8_STAGE(PG8_SB(1, 0), b3, voffB);
            PG8_BAR; PG8_WAIT_L(0); PG8_MMA(0, 1, At, B1); PG8_BAR;
            PG8_LDA(At, 1, 1); PG8_STAGE(PG8_SA(1, 0), a3, voffA);
            PG8_BAR; PG8_WAIT_L(0); PG8_MMA(1, 0, At, B0); PG8_BAR; PG8_SCHED;
            PG8_STAGE(PG8_SB(1, 1), b3 + hstep, voffB);
            PG8_WAIT_V(6); PG8_BAR; PG8_MMA(1, 1, At, B1); PG8_BAR;
            }
        }
        if constexpr (ALIGN_EPI) { if (wr == 0) PG8_BAR; }
        if constexpr (!Epi::AFTER_DRAIN) { E(acc, cur, wr, wc, fr, fq, xl); S.done(cur); }
        if (!has_next) break;
#pragma unroll
        for (int a = 0; a < 2; ++a)
#pragma unroll
            for (int b = 0; b < 2; ++b)
#pragma unroll
                for (int m = 0; m < 4; ++m)
#pragma unroll
                    for (int n = 0; n < 2; ++n) acc[a][b][m][n] = (f32x4){0.f, 0.f, 0.f, 0.f};
        if constexpr (Epi::INIT_ACC) { E.init_issue(ir, nxt, wr, wc, fr, fq); E.init_finish(acc, ir); }
        cur = nxt; cA = nA; cB = nB; ++ui;
        if constexpr (ALIGN_EPI) { if (wr == 1) PG8_BAR; }
    }
    PG8_WAIT_V(0);
    if constexpr (!ALIGN_EPI) { if (wr == 0) PG8_BAR; }
    PG8_BAR;
    if constexpr (Epi::AFTER_DRAIN) { E.fused(acc, cur, wr, wc, fr, fq, xl); S.done(cur); }
#undef PG8_SA
#undef PG8_SB
#undef PG8_STAGE
#undef PG8_LDA
#undef PG8_LDB
#undef PG8_MMA
#undef PG8_WAIT_V
#undef PG8_WAIT_L
#undef PG8_BAR
#undef PG8_SCHED
}
}

typedef GAS unsigned gu32;
#define RLX_AGENT __ATOMIC_RELAXED, __HIP_MEMORY_SCOPE_AGENT
#define XB_TMO      128
#define XB_XCNT(j)  (256  + 64 * (j))
#define XB_XSUB(j)  (1280 + 64 * (j))
#define XB_XGEN(j)  (2304 + 64 * (j))
#define XB_TOP      3328
#define XB_TOPGEN   3392
#define XCD_BAR_WORDS 3456
#define XB_SPIN_CAP (1u << 18)
__device__ __forceinline__ unsigned xb_ld(unsigned* p)              { return __hip_atomic_load(p, __ATOMIC_RELAXED, __HIP_MEMORY_SCOPE_AGENT); }
__device__ __forceinline__ unsigned xb_add(unsigned* p, unsigned v) { return __hip_atomic_fetch_add(p, v, __ATOMIC_RELAXED, __HIP_MEMORY_SCOPE_AGENT); }
__device__ __forceinline__ unsigned xb_xcc_id() { return (unsigned)__builtin_amdgcn_s_getreg((3 << 11) | 20) & 0xFu; }
#define XB_SPIN(cond, bar) do { unsigned _sp = 0; while (cond) { __builtin_amdgcn_s_sleep(1); \
    if ((++_sp & 255u) == 0u) { if (xb_ld(&(bar)[XB_TMO])) break; if (_sp > XB_SPIN_CAP) { atomicAdd(&(bar)[XB_TMO], 1u); break; } } } } while (0)
struct XcdBarrier { unsigned* bar; unsigned x; volatile LAS unsigned* st; };
__device__ __forceinline__ XcdBarrier xcd_barrier_post(unsigned* bar, volatile LAS unsigned* st) {
    XcdBarrier b; b.bar = bar; b.x = xb_xcc_id(); b.st = st;
    if (threadIdx.x == 0) (void)xb_add(&bar[XB_XCNT(b.x)], 1u);
    return b;
}
__device__ __forceinline__ void xcd_barrier_complete(unsigned* bar, unsigned x, unsigned& nloc, unsigned& nx) {
    const unsigned G = gridDim.x * gridDim.y * gridDim.z;
    unsigned sum, cnt, mine, sp = 0u;
    for (;;) {
        sum = 0u; cnt = 0u; mine = 0u;
#pragma unroll
        for (unsigned j = 0; j < 16; ++j) { const unsigned c = xb_ld(&bar[XB_XCNT(j)]); sum += c; cnt += (c > 0u) ? 1u : 0u; mine = (j == x) ? c : mine; }
        if (sum == G) break;
        __builtin_amdgcn_s_sleep(1);
        if ((++sp & 255u) == 0u) { if (xb_ld(&bar[XB_TMO])) break; if (sp > XB_SPIN_CAP) { atomicAdd(&bar[XB_TMO], 1u); break; } }
    }
    nloc = mine > 0u ? mine : 1u; nx = cnt > 0u ? cnt : 1u;
}
__device__ __forceinline__ void xcd_barrier_drain() {
    asm volatile("s_waitcnt vmcnt(0)" ::: "memory");
    __syncthreads();
}
__device__ __forceinline__ void xcd_barrier_sync(const XcdBarrier& b) {
    if (threadIdx.x == 0) {
        unsigned* bar = b.bar;
        __builtin_amdgcn_s_waitcnt(0);
        unsigned nloc = b.st[0], nx = b.st[1];
        if (nloc == 0u) { xcd_barrier_complete(bar, b.x, nloc, nx); b.st[0] = nloc; b.st[1] = nx; }
        const unsigned old = xb_add(&bar[XB_XSUB(b.x)], 1u);
        const unsigned gen = old / nloc;
        if (old + 1u == (gen + 1u) * nloc) {
            __builtin_amdgcn_fence(__ATOMIC_RELEASE, "agent");
            asm volatile("s_waitcnt vmcnt(0)" ::: "memory");
            const unsigned og = xb_add(&bar[XB_TOP], 1u);
            const unsigned tg = og / nx;
            if (og + 1u == (tg + 1u) * nx) xb_add(&bar[XB_TOPGEN], 1u);
            else XB_SPIN(xb_ld(&bar[XB_TOPGEN]) == tg, bar);
            __builtin_amdgcn_fence(__ATOMIC_ACQUIRE, "agent");
            xb_add(&bar[XB_XGEN(b.x)], 1u);
            asm volatile("s_waitcnt vmcnt(0)" ::: "memory");
        } else {
            XB_SPIN(xb_ld(&bar[XB_XGEN(b.x)]) == gen, bar);
            __builtin_amdgcn_fence(__ATOMIC_ACQUIRE, "agent");
            asm volatile("s_waitcnt vmcnt(0)" ::: "memory");
        }
    }
    __syncthreads();
}
__device__ __forceinline__ void xcd_barrier(const XcdBarrier& b) { xcd_barrier_drain(); xcd_barrier_sync(b); }
template <class Grab, class Run>
__device__ __forceinline__ void xcd_barrier_sync_bg(const XcdBarrier& b, Grab grab, Run run) {
    volatile LAS unsigned* st = b.st;
    if (threadIdx.x == 0) {
        unsigned* bar = b.bar;
        __builtin_amdgcn_s_waitcnt(0);
        unsigned nloc = st[0], nx = st[1];
        if (nloc == 0u) { xcd_barrier_complete(bar, b.x, nloc, nx); st[0] = nloc; st[1] = nx; }
        const unsigned old = xb_add(&bar[XB_XSUB(b.x)], 1u);
        const unsigned gen = old / nloc;
        st[2] = (old + 1u == (gen + 1u) * nloc) ? 1u : 0u; st[3] = gen;
    }
    __syncthreads();
    const unsigned leader = st[2], gen = st[3];
    if (leader) {
        if (threadIdx.x == 0) {
            unsigned* bar = b.bar; const unsigned nx = st[1];
            __builtin_amdgcn_fence(__ATOMIC_RELEASE, "agent");
            asm volatile("s_waitcnt vmcnt(0)" ::: "memory");
            const unsigned og = xb_add(&bar[XB_TOP], 1u);
            const unsigned tg = og / nx;
            if (og + 1u == (tg + 1u) * nx) xb_add(&bar[XB_TOPGEN], 1u);
            else XB_SPIN(xb_ld(&bar[XB_TOPGEN]) == tg, bar);
            __builtin_amdgcn_fence(__ATOMIC_ACQUIRE, "agent");
            xb_add(&bar[XB_XGEN(b.x)], 1u);
            asm volatile("s_waitcnt vmcnt(0)" ::: "memory");
        }
        __syncthreads();
        return;
    }
    bool more = true;
    for (unsigned trips = 0;; ++trips) {
        if (threadIdx.x == 0) {
            unsigned* bar = b.bar;
            unsigned done = xb_ld(&bar[XB_XGEN(b.x)]) != gen ? 1u : 0u;
            int chunk = -1;
            if (!done && more && trips < 4096u) chunk = grab();
            if (!done && chunk < 0) { XB_SPIN(xb_ld(&bar[XB_XGEN(b.x)]) == gen, bar); done = 1u; }
            st[4] = done; st[5] = (unsigned)chunk;
        }
        __syncthreads();
        const unsigned done = st[4]; const int chunk = (int)st[5];
        __syncthreads();
        if (done) break;
        run(chunk);
    }
    if (threadIdx.x == 0) {
        __builtin_amdgcn_fence(__ATOMIC_ACQUIRE, "agent");
        asm volatile("s_waitcnt vmcnt(0)" ::: "memory");
    }
    __syncthreads();
}

#define LDS_WAIT() asm volatile("s_waitcnt lgkmcnt(0)" ::: "memory")
__device__ __forceinline__ int t5_bucket(int dist) {
    if (dist < 16) return dist;
    const float v = log2f((float)dist * (1.0f / 16.0f)) * (16.0f / 7.0f);
    const int b = 16 + (int)v;
    return b > 31 ? 31 : b;
}
typedef short v4i16_t __attribute__((ext_vector_type(4)));
__device__ __forceinline__ s16x4 tr4(const LAS unsigned char* p) { return __builtin_bit_cast(s16x4, __builtin_amdgcn_ds_read_tr16_b64_v4i16((LAS v4i16_t*)p)); }
__device__ __forceinline__ int kswz(int j) { return ((j >> 1) & 12) | (j & 3); }
__device__ __forceinline__ int vswz(int j) { return (j & 3) | (((j >> 3) & 1) << 2); }

struct P0Item { const float* W; bf16_t* WT; const float* sc; int K, N, k0, n0; };
__device__ __forceinline__ void p0_load(const P0Item& q, f32x4 (&w)[8], int lane) {
    const float* p = q.W + (size_t)(q.k0 + (lane >> 3)) * q.N + q.n0 + 4 * (lane & 7);
#pragma unroll
    for (int i = 0; i < 8; ++i) w[i] = __builtin_nontemporal_load((const f32x4*)(p + (size_t)(8 * i) * q.N));
}
__device__ __forceinline__ void p0_to_lds(const P0Item& q, const f32x4 (&w)[8], LAS float* scr, int lane) {
#pragma unroll
    for (int i = 0; i < 8; ++i) { const int kk = 8 * i + (lane >> 3); f32x4 v = w[i]; if (q.sc) v = v * q.sc[q.k0 + kk];
        LAS float* d = scr + kk * 33 + 4 * (lane & 7); d[0] = v.x; d[1] = v.y; d[2] = v.z; d[3] = v.w; }
    LDS_WAIT(); asm volatile("" ::: "memory");
}
__device__ __forceinline__ void p0_from_lds(const P0Item& q, LAS float* scr, int lane) {
    const int c = lane & 7;
#pragma unroll
    for (int j = 0; j < 4; ++j) { const int n = (lane >> 3) + 8 * j; const LAS float* s = scr + (8 * c) * 33 + n;
        u32x4 o; o.x = cvt_pk_bf16(s[0 * 33], s[1 * 33]); o.y = cvt_pk_bf16(s[2 * 33], s[3 * 33]); o.z = cvt_pk_bf16(s[4 * 33], s[5 * 33]); o.w = cvt_pk_bf16(s[6 * 33], s[7 * 33]);
        *(u32x4*)(q.WT + (size_t)(q.n0 + n) * q.K + q.k0 + 8 * c) = o; }
    LDS_WAIT(); asm volatile("" ::: "memory");
}

constexpr int P0_I_IN = (DM / 64) * (DIN / 32), P0_I_OUT = (DMIX / 64) * (DM / 32), P0_I_UP = (DM / 64) * (DFF / 32), P0_I_DN = (DFF / 64) * (DM / 32);
constexpr int P0_NITEMS = P0_I_IN + P0_I_OUT + P0_I_UP + P0_I_DN;
struct P0Weights { const float *w_in, *w_out, *w_up, *w_down, *norm_ffn; bf16_t *WinT, *WoutT, *WupT, *WdnT; };
__device__ __forceinline__ P0Item p0_sel(const P0Weights& w, int it) {
    P0Item q; int r = it;
    if (r < P0_I_IN) { q.W = w.w_in; q.WT = w.WinT; q.sc = nullptr; q.K = DM; q.N = DIN; }
    else if ((r -= P0_I_IN) < P0_I_OUT) { q.W = w.w_out; q.WT = w.WoutT; q.sc = nullptr; q.K = DMIX; q.N = DM; }
    else if ((r -= P0_I_OUT) < P0_I_UP) { q.W = w.w_up; q.WT = w.WupT; q.sc = w.norm_ffn; q.K = DM; q.N = DFF; }
    else { r -= P0_I_UP; q.W = w.w_down; q.WT = w.WdnT; q.sc = nullptr; q.K = DFF; q.N = DM; }
    const int nblk = q.N / 32; q.k0 = 64 * (r / nblk); q.n0 = 32 * (r % nblk); return q;
}
struct Args {
    const float* in[17]; float* out; unsigned char* ws; int ph_lo, ph_hi, li, pad;
};

struct AttnDesc { int g, b, hh, r, blk, dil; const bf16_t* Zb; size_t kstride; };
__device__ __forceinline__ AttnDesc attn_decode(const bf16_t* Z, int item) {
    AttnDesc d; d.g = item >> 8; const int rem = item & 255; d.b = rem >> 7; d.hh = (rem >> 5) & 3; const int rb = rem & 31, sh = 2 * d.g;
    d.dil = 1 << sh; d.r = rb >> (5 - sh); d.blk = rb & ((32 >> sh) - 1);
    d.kstride = (size_t)d.dil * DIN;
    d.Zb = Z + (size_t)(d.b * SEQ + d.r) * DIN + d.g * 512 + d.hh * 128;
    return d;
}
__device__ __forceinline__ void attn_loadq(const AttnDesc& d, bf16x8 (&qf)[4], int lane, int wid) {
    const int n = lane & 15, fq = lane >> 4, iq = 16 * wid + n;
    const bf16_t* qsrc = d.Zb + (size_t)(128 * d.blk + iq) * d.kstride + 8 * fq;
#pragma unroll
    for (int ks = 0; ks < 4; ++ks) qf[ks] = *(const bf16x8*)(qsrc + 32 * ks);
}
__device__ __forceinline__ void attn_load(const AttnDesc& d, u32x4 (&kreg)[8], u32x4 (&vreg)[8], int tid, bool carry) {
    const int j0 = tid >> 4, c = tid & 15;
    const bf16_t* src0 = d.Zb + (size_t)((long)(128 * (d.blk - 1) + j0)) * d.kstride + c * 8;
    const size_t istep = 32 * d.kstride;
#pragma unroll
    for (int i = 0; i < 8; ++i) {
        if ((d.blk > 0 && !carry) || i >= 4) { const bf16_t* src = src0 + i * istep; kreg[i] = *(const u32x4*)(src + ZK); vreg[i] = *(const u32x4*)(src + ZV); }
    }
}
__device__ __forceinline__ void attn_stage(const AttnDesc& d, const u32x4 (&kreg)[8], const u32x4 (&vreg)[8], LAS unsigned char* lds, LAS unsigned char* xl, const float* relb, int tid, bool carry, int par, bool newtab) {
    LAS unsigned char* Kl = lds; LAS unsigned char* Vl = lds + 65536; LAS float* bl = (LAS float*)xl;
    const int j0 = tid >> 4, c = tid & 15;
    LAS unsigned char* kd = Kl + j0 * 256 + ((c ^ kswz(j0)) << 4);
    LAS unsigned char* vd = Vl + j0 * 256 + ((((c >> 1) ^ vswz(j0)) << 5) | ((c & 1) << 4));
    const int oprev = par << 15, ocur = (par ^ 1) << 15;
    if (d.blk > 0 && !carry) {
#pragma unroll
        for (int i = 0; i < 4; ++i) { *(LAS u32x4*)(kd + oprev + i * 8192) = kreg[i]; *(LAS u32x4*)(vd + oprev + i * 8192) = vreg[i]; }
    }
#pragma unroll
    for (int i = 0; i < 4; ++i) { *(LAS u32x4*)(kd + ocur + i * 8192) = kreg[4 + i]; *(LAS u32x4*)(vd + ocur + i * 8192) = vreg[4 + i]; }
    if (newtab && tid < 192) { const int dist = tid - 32; bl[tid] = (dist >= 0 && dist <= 128) ? relb[t5_bucket(dist * d.dil) * 12 + d.g * 4 + d.hh] * LOG2E : -INFINITY; }
}
__device__ __forceinline__ void attn_compute(const AttnDesc& d, const bf16x8 (&qf)[4], LAS unsigned char* lds, LAS unsigned char* xl, bf16_t* OG, float* LSE, int lane, int wid, int par) {
    const LAS unsigned char* Kl = lds; const LAS unsigned char* Vl = lds + 65536; const LAS float* bl = (const LAS float*)xl;
    const int n = lane & 15, fq = lane >> 4, iq = 16 * wid + n, blk = d.blk;
    const int G0 = wid >> 1, pofs = par << 15;
    f32x4 sc[5][2];
#pragma unroll
    for (int gi = 0; gi < 5; ++gi) {
        const int G = G0 + gi;
        sc[gi][0] = (f32x4){0.f, 0.f, 0.f, 0.f}; sc[gi][1] = sc[gi][0];
        if (blk == 0 && G < 4) { sc[gi][0] = (f32x4){-INFINITY, -INFINITY, -INFINITY, -INFINITY}; sc[gi][1] = sc[gi][0]; }
        else {
#pragma unroll
            for (int bb = 0; bb < 2; ++bb) {
                const LAS unsigned char* kp = Kl + (((32 * G + 8 * (n >> 2) + 4 * bb + (n & 3)) * 256) ^ pofs);
#pragma unroll
                for (int ks = 0; ks < 4; ++ks) {
                    const bf16x8 kf = *(const LAS bf16x8*)(kp + (((4 * ks + fq) ^ n) << 4));
                    sc[gi][bb] = __builtin_amdgcn_mfma_f32_16x16x32_bf16(kf, qf[ks], sc[gi][bb], 0, 0, 0);
                }
            }
        }
    }
    float mx = -INFINITY;
    const LAS float* blp = bl + (iq + 128 + 32 - 32 * G0 - 8 * fq);
#pragma unroll
    for (int gi = 0; gi < 5; ++gi)
#pragma unroll
        for (int bb = 0; bb < 2; ++bb)
#pragma unroll
            for (int e = 0; e < 4; ++e) {
                const float s = sc[gi][bb][e] + blp[-(32 * gi + 4 * bb + e)];
                sc[gi][bb][e] = s; mx = fmaxf(mx, s);
            }
    mx = fmaxf(mx, __shfl_xor(mx, 16)); mx = fmaxf(mx, __shfl_xor(mx, 32));
    float l = 0.f;
    bf16x8 pf[5];
#pragma unroll
    for (int gi = 0; gi < 5; ++gi) {
        float p[8];
#pragma unroll
        for (int bb = 0; bb < 2; ++bb)
#pragma unroll
            for (int e = 0; e < 4; ++e) { p[4 * bb + e] = __builtin_amdgcn_exp2f(sc[gi][bb][e] - mx); l += p[4 * bb + e]; }
        u32x4 w; w.x = cvt_pk_bf16(p[0], p[1]); w.y = cvt_pk_bf16(p[2], p[3]); w.z = cvt_pk_bf16(p[4], p[5]); w.w = cvt_pk_bf16(p[6], p[7]);
        pf[gi] = __builtin_bit_cast(bf16x8, w);
    }
    l += __shfl_xor(l, 16); l += __shfl_xor(l, 32);
    f32x4 oacc[8];
#pragma unroll
    for (int db = 0; db < 8; ++db) oacc[db] = (f32x4){0.f, 0.f, 0.f, 0.f};
    const int sv = (n >> 2) | ((fq & 1) << 2);
#pragma unroll
    for (int gi = 0; gi < 5; ++gi) {
        const int G = G0 + gi;
        if (blk > 0 || G >= 4) {
            const LAS unsigned char* vp = Vl + (((32 * G + 8 * fq + (n >> 2)) * 256) ^ pofs) + 8 * (n & 3);
#pragma unroll
            for (int db = 0; db < 8; ++db) {
                const LAS unsigned char* a = vp + ((db ^ sv) << 5);
                const s16x4 lo = tr4(a), hi = tr4(a + 1024);
                const bf16x8 vf = (bf16x8){lo[0], lo[1], lo[2], lo[3], hi[0], hi[1], hi[2], hi[3]};
                oacc[db] = __builtin_amdgcn_mfma_f32_16x16x32_bf16(vf, pf[gi], oacc[db], 0, 0, 0);
            }
        }
    }
    const float inv = 1.0f / l;
    const size_t row = (size_t)(d.b * SEQ + d.r) + (size_t)d.dil * (128 * blk + iq);
    bf16_t* op = OG + ((size_t)d.g * MPAD + row) * 512 + d.hh * 128 + 4 * fq;
#pragma unroll
    for (int db = 0; db < 8; ++db) { u32x2 w; w.x = cvt_pk_bf16(oacc[db].x * inv, oacc[db].y * inv); w.y = cvt_pk_bf16(oacc[db].z * inv, oacc[db].w * inv); *(u32x2*)(op + 16 * db) = w; }
    if (fq == 0) LSE[((size_t)d.g * MPAD + row) * 4 + d.hh] = mx + log2f(l);
}

__device__ __forceinline__ void gate_load(const bf16_t* Z, int item, u32x4 (&greg)[4], int tid) {
    const int b = item >> 7, nc = (item >> 2) & 31, g = item & 3, row0 = b * SEQ + 128 * nc;
    const bf16_t* src0 = Z + (size_t)(row0 + (tid >> 4)) * DIN + ZG + g * 128 + (tid & 15) * 8;
#pragma unroll
    for (int i = 0; i < 4; ++i) greg[i] = *(const u32x4*)(src0 + (size_t)i * 32 * DIN);
}
__device__ __forceinline__ void gate_stage(int item, const u32x4 (&greg)[4], LAS unsigned char* lds, LAS unsigned char* xl, const float* ssqg, int tid) {
    const int b = item >> 7, nc = (item >> 2) & 31, row0 = b * SEQ + 128 * nc;
    LAS unsigned char* Gl = lds; LAS float* rl = (LAS float*)xl;
    const int j0 = tid >> 4, c = tid & 15;
    LAS unsigned char* gd = Gl + j0 * 256 + ((((c >> 1) ^ vswz(j0)) << 5) | ((c & 1) << 4));
#pragma unroll
    for (int i = 0; i < 4; ++i) *(LAS u32x4*)(gd + i * 8192) = greg[i];
    if (tid < 128) rl[tid] = __builtin_amdgcn_rsqf((ssqg[(size_t)(row0 + tid) * 2] + ssqg[(size_t)(row0 + tid) * 2 + 1]) * (1.0f / 512.0f) + EPS);
}
struct GateRegs { f32x4 w[4][2]; u32x2 uu[8]; float bt; };
__device__ __forceinline__ void gate_pre(int item, const bf16_t* Z, const float* gw, const float* gb, int lane, int wid, GateRegs& R) {
    const int b = item >> 7, nc = (item >> 2) & 31, g = item & 3, row0 = b * SEQ + 128 * nc;
    const int n = lane & 15, fq = lane >> 4, t = 16 * wid + n;
#pragma unroll
    for (int ks = 0; ks < 4; ++ks) { R.w[ks][0] = (f32x4){0.f, 0.f, 0.f, 0.f}; R.w[ks][1] = R.w[ks][0];
        if (ks <= (wid >> 1)) { const float* wp = gw + ((size_t)g * 128 + t) * 128 + 32 * ks + 8 * fq; R.w[ks][0] = *(const f32x4*)wp; R.w[ks][1] = *(const f32x4*)(wp + 4); } }
    const bf16_t* up = Z + (size_t)(row0 + t) * DIN + ZU + g * 128 + 4 * fq;
#pragma unroll
    for (int cb = 0; cb < 8; ++cb) R.uu[cb] = *(const u32x2*)(up + 16 * cb);
    R.bt = gb[g * 128 + t];
}
__device__ __forceinline__ void gate_compute(int item, LAS unsigned char* lds, LAS unsigned char* xl, const GateRegs& R, const float* vn, bf16_t* MIX, int lane, int wid) {
    const int b = item >> 7, nc = (item >> 2) & 31, g = item & 3, row0 = b * SEQ + 128 * nc;
    const LAS unsigned char* Gl = lds; const LAS float* rl = (const LAS float*)xl;
    const int n = lane & 15, fq = lane >> 4, t = 16 * wid + n;
    f32x4 acc[8];
#pragma unroll
    for (int cb = 0; cb < 8; ++cb) acc[cb] = (f32x4){0.f, 0.f, 0.f, 0.f};
    const int sv = (n >> 2) | ((fq & 1) << 2);
#pragma unroll
    for (int ks = 0; ks < 4; ++ks) {
        if (ks <= (wid >> 1)) {
            const int s0 = 32 * ks + 8 * fq;
            const f32x4 w0 = R.w[ks][0], w1 = R.w[ks][1];
            const f32x4 r0 = *(const LAS f32x4*)(rl + s0), r1 = *(const LAS f32x4*)(rl + s0 + 4);
            float wv[8] = {w0.x * r0.x, w0.y * r0.y, w0.z * r0.z, w0.w * r0.w, w1.x * r1.x, w1.y * r1.y, w1.z * r1.z, w1.w * r1.w};
#pragma unroll
            for (int e = 0; e < 8; ++e) wv[e] = (s0 + e <= t) ? wv[e] : 0.f;
            u32x4 w; w.x = cvt_pk_bf16(wv[0], wv[1]); w.y = cvt_pk_bf16(wv[2], wv[3]); w.z = cvt_pk_bf16(wv[4], wv[5]); w.w = cvt_pk_bf16(wv[6], wv[7]);
            const bf16x8 wf = __builtin_bit_cast(bf16x8, w);
            const LAS unsigned char* vp = Gl + (32 * ks + 8 * fq + (n >> 2)) * 256 + 8 * (n & 3);
#pragma unroll
            for (int cb = 0; cb < 8; ++cb) {
                const LAS unsigned char* a = vp + ((cb ^ sv) << 5);
                const s16x4 lo = tr4(a), hi = tr4(a + 1024);
                const bf16x8 gf = (bf16x8){lo[0], lo[1], lo[2], lo[3], hi[0], hi[1], hi[2], hi[3]};
                acc[cb] = __builtin_amdgcn_mfma_f32_16x16x32_bf16(gf, wf, acc[cb], 0, 0, 0);
            }
        }
    }
    const float bt = R.bt;
    bf16_t* mp = MIX + (size_t)(row0 + t) * DMIX + 512 + g * 128 + 4 * fq;
#pragma unroll
    for (int cb = 0; cb < 8; ++cb) {
        const f32x4 gn = *(const f32x4*)(vn + g * 128 + 16 * cb + 4 * fq);
        const u32x2 uu = R.uu[cb];
        const f32x4 mixed = acc[cb] * gn + bt;
        u32x2 w; w.x = cvt_pk_bf16(bf_lo(uu.x) * mixed.x, bf_hi(uu.x) * mixed.y); w.y = cvt_pk_bf16(bf_lo(uu.y) * mixed.z, bf_hi(uu.y) * mixed.w);
        *(u32x2*)(mp + 16 * cb) = w;
    }
}

struct SRegs { float k0[19], k1[19], v0[19], v1[19]; unsigned qq; };
__device__ __forceinline__ void sattn_load_cache(const float* cache, int g, int rem, int lane, int wid, SRegs& R) {
    const int db = rem >> 4, hh = (rem >> 2) & 3, t = rem & 3;
    const int sh = 2 * g, dil = 1 << sh, L = 128 << sh;
    const size_t hoff = (size_t)hh * 128 + 2 * lane;
#pragma unroll
    for (int k = 0; k < 19; ++k) {
        const int s = (wid - 1) + 7 * k, idx = L + t - s * dil; R.k0[k] = 0.f; R.k1[k] = 0.f; R.v0[k] = 0.f; R.v1[k] = 0.f;
        if (wid > 0 && s <= 128 && idx < L) { const float* cp = cache + ((size_t)(db * 2 + 0) * L + idx) * 512 + hoff; const f32x2 kk = __builtin_nontemporal_load((const f32x2*)cp), vv = __builtin_nontemporal_load((const f32x2*)(cp + (size_t)L * 512));
            R.k0[k] = kk.x; R.k1[k] = kk.y; R.v0[k] = vv.x; R.v1[k] = vv.y; }
    }
}
__device__ __forceinline__ void sattn_load_new(const bf16_t* Z, int g, int rem, int lane, int wid, SRegs& R) {
    const int db = rem >> 4, hh = (rem >> 2) & 3, t = rem & 3;
    const int sh = 2 * g, dil = 1 << sh, L = 128 << sh;
    const size_t hoff = (size_t)hh * 128 + 2 * lane;
    R.qq = *(const unsigned*)(Z + (size_t)(MP + db * 4 + t) * DIN + g * 512 + hoff);
#pragma unroll
    for (int k = 0; k < 1; ++k) {
        const int s = (wid - 1) + 7 * k, idx = L + t - s * dil;
        if (wid > 0 && s <= 128 && idx >= L) { const bf16_t* zp = Z + (size_t)(MP + db * 4 + (idx - L)) * DIN + g * 512 + hoff; const unsigned kk = *(const unsigned*)(zp + ZK), vv = *(const unsigned*)(zp + ZV);
            R.k0[k] = bf_lo(kk); R.k1[k] = bf_hi(kk); R.v0[k] = bf_lo(vv); R.v1[k] = bf_hi(vv); }
    }
}
__device__ __forceinline__ LAS float* sattn_bl(LAS unsigned char* xl, int sl) { return (LAS float*)(xl + 6144 + 1024 * sl); }
__device__ __forceinline__ LAS float* sattn_red(LAS unsigned char* xl, int sl) { return (LAS float*)(xl + (sl ? 8192 : 1024)); }
__device__ __forceinline__ LAS float* sattn_ml(LAS unsigned char* xl, int sl) { return (LAS float*)(xl + 5120 + 64 * sl); }
__device__ __forceinline__ void sattn_bias(LAS unsigned char* xl, int sl, const float* relb, int g, int rem, int tid, int t0) {
    const int hh = (rem >> 2) & 3, dil = 1 << (2 * g), i = tid - t0;
    if (i >= 0 && i < 129) sattn_bl(xl, sl)[i] = relb[t5_bucket(i * dil) * 12 + g * 4 + hh] * LOG2E;
}
__device__ __forceinline__ void sattn_partial(LAS unsigned char* xl, int sl, const bf16_t* Z, int g, int rem, int lane, int wid, const SRegs& R) {
    const int db = rem >> 4, hh = (rem >> 2) & 3, t = rem & 3;
    const LAS float* bl = sattn_bl(xl, sl); LAS float* red = sattn_red(xl, sl); LAS float* ml = sattn_ml(xl, sl);
    const unsigned qq = R.qq;
    const float (&k0)[19] = R.k0; const float (&k1)[19] = R.k1; const float (&v0)[19] = R.v0; const float (&v1)[19] = R.v1;
    const float q0 = bf_lo(qq), q1 = bf_hi(qq);
    const int c = lane & 15;
    float pa = 0.f, pb = 0.f;
#pragma unroll
    for (int k = 0; k < 19; ++k) { const float r = row_sum16(q0 * k0[k] + q1 * k1[k]); if (k < 16) pa = (c == k) ? r : pa; else pb = (c == k - 16) ? r : pb; }
    pa += __shfl_xor(pa, 16); pa += __shfl_xor(pa, 32); pb += __shfl_xor(pb, 16); pb += __shfl_xor(pb, 32);
    const int sme = (wid - 1) + 7 * lane;
    const bool okme = wid > 0 && lane < 19 && sme <= 128;
    const float mys = okme ? (lane < 16 ? pa : pb) + bl[okme ? sme : 0] : -INFINITY;
    const float mw = wave_max(mys);
    const float p = wid > 0 ? __builtin_amdgcn_exp2f(mys - mw) : 0.f;
    const float lw = wave_sum(p);
    float o0 = 0.f, o1 = 0.f;
#pragma unroll
    for (int k = 0; k < 19; ++k) { const float pk = __uint_as_float(__builtin_amdgcn_readlane(__float_as_uint(p), k)); o0 += pk * v0[k]; o1 += pk * v1[k]; }
    red[wid * 128 + 2 * lane] = o0; red[wid * 128 + 2 * lane + 1] = o1;
    if (lane == 0) { ml[wid] = mw; ml[8 + wid] = lw; }
}
__device__ __forceinline__ void sattn_combine(LAS unsigned char* xl, int sl, bf16_t* OG, float* LSE, int g, int rem, int tid, int t0) {
    const int db = rem >> 4, hh = (rem >> 2) & 3, t = rem & 3, qrow = MP + db * 4 + t, i = tid - t0;
    if (i < 0 || i >= 128) return;
    const LAS float* red = sattn_red(xl, sl); const LAS float* ml = sattn_ml(xl, sl);
    float M = ml[0];
#pragma unroll
    for (int w = 1; w < 8; ++w) M = fmaxf(M, ml[w]);
    float Ls = 0.f, o = 0.f;
#pragma unroll
    for (int w = 0; w < 8; ++w) { const float f = __builtin_amdgcn_exp2f(ml[w] - M); Ls += ml[8 + w] * f; o += red[w * 128 + i] * f; }
    o = o / Ls;
    const float on = __shfl_down(o, 1);
    if ((i & 1) == 0) *(unsigned*)(OG + ((size_t)g * MPAD + qrow) * 512 + hh * 128 + i) = cvt_pk_bf16(o, on);
    if (i == 0) LSE[((size_t)g * MPAD + qrow) * 4 + hh] = M + log2f(Ls);
}

__device__ __forceinline__ void sgate_item(const bf16_t* Z, const float* ssqg, const float* gw, const float* gb, const float* vn, bf16_t* MIX, float* out, int tid) {
    const int db = tid >> 6, c0 = 8 * (tid & 63), grp = c0 >> 7;
    const f32x4 ga = *(const f32x4*)(vn + c0), gb4 = *(const f32x4*)(vn + c0 + 4);
    u32x4 gg[4], uu[4]; float sq[4][2], bt[4], wt[4][4];
#pragma unroll
    for (int s = 0; s < 4; ++s) {
        const int row = MP + db * 4 + s;
        sq[s][0] = ssqg[(size_t)row * 2]; sq[s][1] = ssqg[(size_t)row * 2 + 1];
        gg[s] = *(const u32x4*)(Z + (size_t)row * DIN + ZG + c0);
        uu[s] = *(const u32x4*)(Z + (size_t)row * DIN + ZU + c0);
        bt[s] = gb[grp * 128 + s];
#pragma unroll
        for (int t = 0; t < 4; ++t) wt[t][s] = (s <= t) ? gw[((size_t)grp * 128 + t) * 128 + s] : 0.f;
    }
    const float gain[8] = {ga.x, ga.y, ga.z, ga.w, gb4.x, gb4.y, gb4.z, gb4.w};
    float gn[4][8];
#pragma unroll
    for (int s = 0; s < 4; ++s) {
        const float rinv = __builtin_amdgcn_rsqf((sq[s][0] + sq[s][1]) * (1.0f / 512.0f) + EPS);
#pragma unroll
        for (int j = 0; j < 4; ++j) { gn[s][2 * j] = bf_lo(gg[s][j]) * rinv * gain[2 * j]; gn[s][2 * j + 1] = bf_hi(gg[s][j]) * rinv * gain[2 * j + 1]; }
        float* op = out + OUT_GV + (size_t)(db * 4 + s) * 512 + c0;
        *(f32x4*)op = (f32x4){gn[s][0], gn[s][1], gn[s][2], gn[s][3]}; *(f32x4*)(op + 4) = (f32x4){gn[s][4], gn[s][5], gn[s][6], gn[s][7]};
    }
#pragma unroll
    for (int t = 0; t < 4; ++t) {
        const int row = MP + db * 4 + t;
        float mixed[8];
#pragma unroll
        for (int e = 0; e < 8; ++e) mixed[e] = bt[t];
#pragma unroll
        for (int s = 0; s < 4; ++s) if (s <= t) {
#pragma unroll
            for (int e = 0; e < 8; ++e) mixed[e] += wt[t][s] * gn[s][e]; }
        u32x4 w;
#pragma unroll
        for (int j = 0; j < 4; ++j) w[j] = cvt_pk_bf16(bf_lo(uu[t][j]) * mixed[2 * j], bf_hi(uu[t][j]) * mixed[2 * j + 1]);
        *(u32x4*)(MIX + (size_t)row * DMIX + 512 + c0) = w;
    }
}

template <class F, class Pro>
__device__ __forceinline__ void skinny_gemm(LAS unsigned char* lds, volatile LAS unsigned* slot, unsigned* qcnt, const bf16_t* A, const bf16_t* Bt, int K, int N, int KP, int tid, int lane, int wid, const F& f, const Pro& pro) {
    LAS float* red = (LAS float*)lds;
    const int n = lane & 15, fq = lane >> 4, nblk = N / 32, nitems = nblk * KP, kpart = K / KP, kw = kpart / 8;
    bool first = true;
    for (;;) {
        if (tid == 0) *slot = __hip_atomic_fetch_add(qcnt, 1u, __ATOMIC_RELAXED, __HIP_MEMORY_SCOPE_AGENT);
        __syncthreads();
        const int it = (int)*slot;
        if (it >= nitems) break;
        if (first) { pro(); first = false; }
        const int ib = it % nblk, kp = it / nblk, n0 = 32 * ib, kb = kp * kpart + wid * kw;
        f32x4 a00 = (f32x4){0.f, 0.f, 0.f, 0.f}, a01 = a00, a10 = a00, a11 = a00;
        const bf16_t* wp = Bt + (size_t)(n0 + n) * K + kb + 8 * fq;
        const bf16_t* ap = A + (size_t)n * K + kb + 8 * fq;
#pragma unroll 4
        for (int k = 0; k < kw; k += 32) {
            const bf16x8 w0 = *(const bf16x8*)(wp + k), w1 = *(const bf16x8*)(wp + (size_t)16 * K + k), x0 = *(const bf16x8*)(ap + k), x1 = *(const bf16x8*)(ap + (size_t)16 * K + k);
            a00 = __builtin_amdgcn_mfma_f32_16x16x32_bf16(w0, x0, a00, 0, 0, 0);
            a01 = __builtin_amdgcn_mfma_f32_16x16x32_bf16(w0, x1, a01, 0, 0, 0);
            a10 = __builtin_amdgcn_mfma_f32_16x16x32_bf16(w1, x0, a10, 0, 0, 0);
            a11 = __builtin_amdgcn_mfma_f32_16x16x32_bf16(w1, x1, a11, 0, 0, 0);
        }
        *(LAS f32x4*)(red + (((wid * 2 + 0) * 2 + 0) * 16 + n) * 16 + 4 * fq) = a00;
        *(LAS f32x4*)(red + (((wid * 2 + 0) * 2 + 1) * 16 + n) * 16 + 4 * fq) = a01;
        *(LAS f32x4*)(red + (((wid * 2 + 1) * 2 + 0) * 16 + n) * 16 + 4 * fq) = a10;
        *(LAS f32x4*)(red + (((wid * 2 + 1) * 2 + 1) * 16 + n) * 16 + 4 * fq) = a11;
        __syncthreads();
#pragma unroll
        for (int j = 0; j < 2; ++j) {
            const int o = tid + 512 * j, row = o >> 5, col = o & 31;
            float v = 0.f;
#pragma unroll
            for (int w = 0; w < 8; ++w) v += red[(((w * 2 + (col >> 4)) * 2 + (row >> 4)) * 16 + (row & 15)) * 16 + (col & 15)];
            f(row, n0 + col, v, ib, kp);
        }
        __syncthreads();
    }
}

constexpr int NPH = 7;
__global__ void __launch_bounds__(512, 2) hymba_fwd(Args args) {
    extern __shared__ __attribute__((aligned(16))) unsigned char lds_raw[];
    LAS unsigned char* lds = (LAS unsigned char*)lds_raw;
    LAS unsigned char* xl = lds + XL_OFF;
    volatile LAS unsigned* MISC = (volatile LAS unsigned*)(lds + MISC_OFF);
    const int tid = threadIdx.x, lane = tid & 63, wid = __builtin_amdgcn_readfirstlane(tid >> 6);
    const int G = gridDim.x, bx = blockIdx.x, vcu = (G % 8 == 0) ? (bx % 8) * (G / 8) + bx / 8 : bx;
    unsigned char* ws = args.ws;
    unsigned* ctl = (unsigned*)(ws + WS_CTL);
    const float* x_p = args.in[0]; const float* x_s = args.in[1]; const float* c128 = args.in[2]; const float* c512 = args.in[3]; const float* c2048 = args.in[4];
    const float* norm_mix = args.in[5]; const float* w_in = args.in[6]; const float* q_norm = args.in[7]; const float* k_norm = args.in[8]; const float* rel_bias = args.in[9];
    const float* v_norm = args.in[10]; const float* gmlp_w = args.in[11]; const float* gmlp_b = args.in[12]; const float* w_out = args.in[13]; const float* norm_ffn = args.in[14];
    const float* w_up = args.in[15]; const float* w_down = args.in[16];
    float* out = args.out;
    bf16_t* WinT = (bf16_t*)(ws + WS_WIN); bf16_t* WoutT = (bf16_t*)(ws + WS_WOUT); bf16_t* WupT = (bf16_t*)(ws + WS_WUP); bf16_t* WdnT = (bf16_t*)(ws + WS_WDN);
    bf16_t* H = (bf16_t*)(ws + WS_H); bf16_t* Z = (bf16_t*)(ws + WS_Z); bf16_t* OG = (bf16_t*)(ws + WS_OG); bf16_t* MIX = (bf16_t*)(ws + WS_MIX); bf16_t* ACT = (bf16_t*)(ws + WS_ACT);
    float* SSQG = (float*)(ws + WS_SSQG); float* LSE = (float*)(ws + WS_LSE); float* SSQ2 = (float*)(ws + WS_SSQ2); float* SSQ2S = (float*)(ws + WS_SSQ2S);

    const P0Weights WP{w_in, w_out, w_up, w_down, norm_ffn, WinT, WoutT, WupT, WdnT};
    for (int u = tid; u < 32; u += 512) MISC[u] = 0u;
    __syncthreads();
    XcdBarrier bar; bar.bar = ctl + CW_BAR + args.li * XCD_BAR_WORDS; bar.x = 0; bar.st = nullptr;
    if (MK_N_LAUNCHES == 1) bar = xcd_barrier_post(ctl + CW_BAR + args.li * XCD_BAR_WORDS, MISC + 8);
#define STAMP(i) do { if (PROBE_T >= 0 && bx == PROBE_T_BX && tid == 0) MISC[16 + (i)] = (unsigned)__builtin_amdgcn_s_memrealtime(); } while (0)
    const int lo = args.ph_lo, hi = args.ph_hi;
#define IN(k) (lo <= (k) && (k) < hi)
#ifndef PROBE_DBLBAR
#define PROBE_DBLBAR 0
#endif
#define SEAM(k) do { if (IN(k) && IN((k) + 1)) { STAMP(2 * (k) + 1); \
        if ((k) >= 2 && (k) <= 4 && MK_N_LAUNCHES == 1 && PROBE_LO < 0) { if ((k) == 3) bg_flush(NCHUNK_OUT); if ((k) == 4) bg_flush(NCHUNK_UP); xcd_barrier_drain(); xcd_barrier_sync_bg(bar, bg_grab, bg_run); } \
        else { if ((k) == 5 && MK_N_LAUNCHES == 1 && PROBE_LO < 0) bg_flush(NCHUNK); xcd_barrier(bar); } \
        STAMP(2 * (k) + 2); } } while (0)
    const int gw = vcu * 8 + wid, NGW = G * 8;
    constexpr int NDEF = P0_NITEMS - P0_I_IN, nearly = 0;
    constexpr int NCHUNK = (NDEF + 15) / 16, NCHUNK_OUT = (P0_I_OUT + 15) / 16, NCHUNK_UP = (P0_I_OUT + P0_I_UP + 15) / 16;
    unsigned* const bgq = ctl + CW_QUEUE;
    auto bg_grab = [&]() -> int { const unsigned c = __hip_atomic_fetch_add(bgq, 1u, __ATOMIC_RELAXED, __HIP_MEMORY_SCOPE_AGENT); return c < (unsigned)NCHUNK ? (int)c : -1; };
    auto bg_run = [&](int chunk) {
        int ln = threadIdx.x; asm volatile("" : "+v"(ln)); ln &= 63;
        LAS float* scr = (LAS float*)(lds + wid * 16384);
        const int i0 = P0_I_IN + nearly + chunk * 16 + wid, i1 = i0 + 8;
        f32x4 w0[8], w1[8];
        if (i0 < P0_NITEMS) { const P0Item q = p0_sel(WP, i0); p0_load(q, w0, ln); }
        if (i1 < P0_NITEMS) { const P0Item q = p0_sel(WP, i1); p0_load(q, w1, ln); }
        if (i0 < P0_NITEMS) { const P0Item q = p0_sel(WP, i0); p0_to_lds(q, w0, scr, ln); p0_from_lds(q, scr, ln); }
        if (i1 < P0_NITEMS) { const P0Item q = p0_sel(WP, i1); p0_to_lds(q, w1, scr, ln); p0_from_lds(q, scr, ln); }
    };
    auto bg_flush = [&](int upto) {
        for (;;) {
            if (tid == 0) MISC[13] = (unsigned)(((int)__hip_atomic_load(bgq, __ATOMIC_RELAXED, __HIP_MEMORY_SCOPE_AGENT) < upto) ? bg_grab() : -1);
            __syncthreads();
            const int chunk = (int)MISC[13];
            __syncthreads();
            if (chunk < 0) break;
            bg_run(chunk);
        }
    };

    STAMP(0);
    if (IN(0)) {
        LAS float* scr = (LAS float*)(lds + wid * 16384);
        f32x4 wreg[8];
        if (gw < P0_I_IN) { const P0Item q0 = p0_sel(WP, gw); p0_load(q0, wreg, lane); }
        for (int it = gw; it < P0_I_IN; it += NGW) {
            const P0Item q = p0_sel(WP, it);
            p0_to_lds(q, wreg, scr, lane);
            if (it + NGW < P0_I_IN) { const P0Item qn = p0_sel(WP, it + NGW); p0_load(qn, wreg, lane); }
            p0_from_lds(q, scr, lane);
        }
        {
            auto xrow = [=](int row) -> const f32x4* { return (const f32x4*)(row < MP ? x_p + (size_t)row * DM : x_s + (size_t)(row - MP) * DM); };
            f32x4 v[8], vn[8];
            const int gwr = (gw + NGW - P0_I_IN % NGW) % NGW;
            if (gwr < MV) { const f32x4* xr = xrow(gwr);
#pragma unroll
                for (int j = 0; j < 8; ++j) v[j] = __builtin_nontemporal_load(xr + lane + 64 * j); }
            for (int row = gwr; row < MPAD; row += NGW) {
                u32x2* hp = (u32x2*)(H + (size_t)row * DM);
                const int nrow = row + NGW;
                if (nrow < MV) { const f32x4* xr = xrow(nrow);
#pragma unroll
                    for (int j = 0; j < 8; ++j) vn[j] = __builtin_nontemporal_load(xr + lane + 64 * j); }
                if (row < MV) {
                    float s = 0.f;
#pragma unroll
                    for (int j = 0; j < 8; ++j) s += dot4(v[j]);
                    const float rinv = __builtin_amdgcn_rsqf(wave_sum(s) * (1.0f / DM) + EPS);
#pragma unroll
                    for (int j = 0; j < 8; ++j) { const f32x4 gn = ((const f32x4*)norm_mix)[lane + 64 * j]; const f32x4 o = v[j] * rinv * gn;
                        u32x2 w; w.x = cvt_pk_bf16(o.x, o.y); w.y = cvt_pk_bf16(o.z, o.w); hp[lane + 64 * j] = w; }
                } else {
#pragma unroll
                    for (int j = 0; j < 8; ++j) hp[lane + 64 * j] = (u32x2){0u, 0u};
                }
#pragma unroll
                for (int j = 0; j < 8; ++j) v[j] = vn[j];
            }
        }
    }
    SEAM(0);
    SRegs RA, RB; bool spre = false;
    const int sit0 = vcu, sit1 = vcu + G;
#if CODE_PAD1 > 0
    asm volatile(".rept %0\n s_nop 0\n .endr" :: "n"(CODE_PAD1));
#endif
    if (IN(1)) {
        pg8::Gemm g{H, WinT, MPAD, DIN, DM}; pg8::StaticOrder S; S.init(MPAD, DIN, G, bx);
        pg8::EpiZ E{Z, out, q_norm, k_norm, SSQG};
        pg8::gemm_phase<pg8::EpiZ, pg8::StaticOrder, true, true>(lds, xl, g, S, E);
        __syncthreads();
        if (!(MK_N_LAUNCHES == 1 && PROBE_LO < 0)) bg_flush(NCHUNK);
    }
    if (IN(1) && IN(2)) {
        STAMP(3);
        xcd_barrier_drain();
        if (G >= 192) {
            if (sit0 < 384) { const int g = sit0 >> 7; sattn_load_cache(g == 0 ? c128 : (g == 1 ? c512 : c2048), g, sit0 & 127, lane, wid, RA); }
            if (sit1 < 384) { const int g = sit1 >> 7; sattn_load_cache(g == 0 ? c128 : (g == 1 ? c512 : c2048), g, sit1 & 127, lane, wid, RB); }
            if (sit0 < 384) sattn_bias(xl, 0, rel_bias, sit0 >> 7, sit0 & 127, tid, 0);
            if (sit1 < 384) sattn_bias(xl, 1, rel_bias, sit1 >> 7, sit1 & 127, tid, 256);
            spre = true;
        }
        if (MK_N_LAUNCHES == 1 && PROBE_LO < 0) xcd_barrier_sync_bg(bar, bg_grab, bg_run); else xcd_barrier_sync(bar);
        STAMP(4);
    }
    if (IN(2)) {
        const int skip = args.pad;
        u32x4 kreg[8], vreg[8]; bool apre = false;
        if (!(skip & 4)) {
            if (spre) {
                if (sit0 < 384) sattn_load_new(Z, sit0 >> 7, sit0 & 127, lane, wid, RA);
                if (sit1 < 384) sattn_load_new(Z, sit1 >> 7, sit1 & 127, lane, wid, RB);
                if (!(skip & 1) && vcu * 3 < 768) { const AttnDesc d0 = attn_decode(Z, vcu * 3); attn_load(d0, kreg, vreg, tid, false); apre = true; }
                if (sit0 < 384) sattn_partial(xl, 0, Z, sit0 >> 7, sit0 & 127, lane, wid, RA);
                if (sit1 < 384) sattn_partial(xl, 1, Z, sit1 >> 7, sit1 & 127, lane, wid, RB);
                __syncthreads();
                if (sit0 < 384) sattn_combine(xl, 0, OG, LSE, sit0 >> 7, sit0 & 127, tid, 0);
                if (sit1 < 384) sattn_combine(xl, 1, OG, LSE, sit1 >> 7, sit1 & 127, tid, 128);
                __syncthreads();
            } else for (int it = vcu; it < 384; it += G) {
                const int g = it >> 7;
                sattn_load_cache(g == 0 ? c128 : (g == 1 ? c512 : c2048), g, it & 127, lane, wid, RA);
                sattn_load_new(Z, g, it & 127, lane, wid, RA);
                sattn_bias(xl, 0, rel_bias, g, it & 127, tid, 0);
                __syncthreads();
                sattn_partial(xl, 0, Z, g, it & 127, lane, wid, RA);
                __syncthreads();
                sattn_combine(xl, 0, OG, LSE, g, it & 127, tid, 0);
                __syncthreads();
            }
        }
        u32x4 greg[4]; bool gpre = false;
        if (!(skip & 1)) for (int it = vcu * 3; it < 768; it += 3 * G) {
            if (!(apre && it == vcu * 3)) { const AttnDesc d0 = attn_decode(Z, it); attn_load(d0, kreg, vreg, tid, false); }
            bool carry = false; int par = 0;
#pragma unroll
            for (int i = 0; i < 3; ++i) {
                const AttnDesc d = attn_decode(Z, it + i);
                bf16x8 qf[4];
                attn_loadq(d, qf, lane, wid);
                attn_stage(d, kreg, vreg, lds, xl, rel_bias, tid, carry, par, i == 0 || ((it + i) & 31) == 0);
                __syncthreads();
                bool carry_n = false;
                if (i < 2) { const AttnDesc dn = attn_decode(Z, it + i + 1); carry_n = dn.blk != 0; attn_load(dn, kreg, vreg, tid, carry_n); }
                attn_compute(d, qf, lds, xl, OG, LSE, lane, wid, par);
                __syncthreads();
                par = carry_n ? (par ^ 1) : 0; carry = carry_n;
            }
        }
        if (!(skip & 2)) for (int it = vcu; it < 256; it += G) {
            if (!(gpre && it == vcu)) gate_load(Z, it, greg, tid);
            GateRegs GR; gate_pre(it, Z, gmlp_w, gmlp_b, lane, wid, GR);
            gate_stage(it, greg, lds, xl, SSQG, tid);
            __syncthreads();
            gate_compute(it, lds, xl, GR, v_norm, MIX, lane, wid);
            __syncthreads();
        }
        if (!(skip & 8) && vcu == G - 1) sgate_item(Z, SSQG, gmlp_w, gmlp_b, v_norm, MIX, out, tid);
    }
    SEAM(2);
#if CODE_PAD > 0
    asm volatile(".rept %0\n s_nop 0\n .endr" :: "n"(CODE_PAD));
#endif
    if (IN(3)) {
        const int hh = lane >> 4;
        for (int row0 = gw; row0 < MV; row0 += 5 * NGW) {
            float l[5][3]; u32x4 o[5][3];
#pragma unroll
            for (int r = 0; r < 5; ++r) { const int row = row0 + r * NGW; if (row < MV) {
#pragma unroll
                for (int g = 0; g < 3; ++g) { l[r][g] = LSE[((size_t)g * MPAD + row) * 4 + hh]; o[r][g] = __builtin_nontemporal_load((const u32x4*)(OG + ((size_t)g * MPAD + row) * 512 + 8 * lane)); } } }
#pragma unroll
            for (int r = 0; r < 5; ++r) { const int row = row0 + r * NGW; if (row < MV) {
                const float M = fmaxf(l[r][0], fmaxf(l[r][1], l[r][2]));
                float a0 = __builtin_amdgcn_exp2f(l[r][0] - M), a1 = __builtin_amdgcn_exp2f(l[r][1] - M), a2 = __builtin_amdgcn_exp2f(l[r][2] - M);
                const float inv = 1.0f / (a0 + a1 + a2); a0 *= inv; a1 *= inv; a2 *= inv;
                u32x4 w;
#pragma unroll
                for (int j = 0; j < 4; ++j) {
                    const float lo_ = a0 * bf_lo(o[r][0][j]) + a1 * bf_lo(o[r][1][j]) + a2 * bf_lo(o[r][2][j]);
                    const float hi_ = a0 * bf_hi(o[r][0][j]) + a1 * bf_hi(o[r][1][j]) + a2 * bf_hi(o[r][2][j]);
                    w[j] = cvt_pk_bf16(lo_, hi_);
                }
                *(u32x4*)(MIX + (size_t)row * DMIX + 8 * lane) = w; } }
        }
    }
    SEAM(3);
    if (IN(4)) {
        pg8::Gemm g{MIX, WoutT, MP, DM, DMIX}; pg8::StaticOrder S; S.init(MP, DM, G, bx);
        pg8::EpiX1 E{x_p, out, H, SSQ2};
        pg8::gemm_phase<pg8::EpiX1, pg8::StaticOrder, false, true>(lds, xl, g, S, E);
        __syncthreads();
        skinny_gemm(lds, MISC + 15, ctl + CW_SKINNY, MIX + (size_t)MP * DMIX, WoutT, DMIX, DM, 1, tid, lane, wid, [=](int row, int col, float v, int ib, int) {
            const float x1 = x_s[(size_t)row * DM + col] + v;
            out[OUT_Y + (size_t)(MP + row) * DM + col] = x1;
            H[(size_t)(MP + row) * DM + col] = (bf16_t)(cvt_pk_bf16(x1, 0.f) & 0xffffu);
            float s = x1 * x1;
            s += __shfl_xor(s, 1); s += __shfl_xor(s, 2); s += __shfl_xor(s, 4); s += __shfl_xor(s, 8); s += __shfl_xor(s, 16);
            if ((col & 31) == 0) SSQ2S[row * 64 + ib] = s;
        }, []() {});
    }
    SEAM(4);
    if (IN(5)) {
        pg8::Gemm g{H, WupT, MP, DFF, DM}; pg8::StaticOrder S; S.init(MP, DFF, G, bx);
        pg8::EpiAct E{ACT, SSQ2};
        pg8::gemm_phase<pg8::EpiAct, pg8::StaticOrder, true, true>(lds, xl, g, S, E);
        __syncthreads();
        LAS float* rs = (LAS float*)xl;
        skinny_gemm(lds, MISC + 15, ctl + CW_SKINNY + 64, H + (size_t)MP * DM, WupT, DM, DFF, 1, tid, lane, wid, [=](int row, int col, float v, int, int) {
            float a = fmaxf(v * rs[row], 0.f); a = a * a;
            ACT[(size_t)(MP + row) * DFF + col] = (bf16_t)(cvt_pk_bf16(a, 0.f) & 0xffffu);
        }, [=]() {
            const int row = tid >> 4, part = tid & 15; float s = 0.f;
#pragma unroll
            for (int j = 0; j < 4; ++j) s += SSQ2S[row * 64 + part * 4 + j];
            s += __shfl_xor(s, 1); s += __shfl_xor(s, 2); s += __shfl_xor(s, 4); s += __shfl_xor(s, 8);
            if (part == 0) rs[row] = __builtin_amdgcn_rsqf(s * (1.0f / DM) + EPS);
        });
    }
    SEAM(5);
    if (IN(6)) {
        pg8::Gemm g{ACT, WdnT, MP, DM, DFF}; pg8::StaticOrder S; S.init(MP, DM, G, bx);
        pg8::EpiY E{out, H};
        pg8::gemm_phase<pg8::EpiY, pg8::StaticOrder, true, true>(lds, xl, g, S, E);
        __syncthreads();
        skinny_gemm(lds, MISC + 15, ctl + CW_SKINNY + 128, ACT + (size_t)MP * DFF, WdnT, DFF, DM, 4, tid, lane, wid, [=](int row, int col, float v, int, int) {
            atomicAdd(out + OUT_Y + (size_t)(MP + row) * DM + col, v);
        }, []() {});
    }
    if (PROBE_T >= 0 && bx == PROBE_T_BX && tid == 0) {
        MISC[16 + 13] = (unsigned)__builtin_amdgcn_s_memrealtime();
        const int a = PROBE_T < 7 ? 2 * PROBE_T : 2 * (PROBE_T - 7) + 1;
        const int b = PROBE_T < 6 ? 2 * PROBE_T + 2 : (PROBE_T == 6 ? 13 : 2 * (PROBE_T - 7) + 2);
        const unsigned d = MISC[16 + b] - MISC[16 + a];
        const unsigned long long t0 = __builtin_amdgcn_s_memrealtime();
        while (__builtin_amdgcn_s_memrealtime() - t0 < (unsigned long long)d * PROBE_T_AMP) __builtin_amdgcn_s_sleep(16);
    }
#undef IN
#undef SEAM
}

extern "C" void kernel_launch(void* const* d_in, const int* in_sizes, int n_in, void* d_out, int out_size, void* d_ws, size_t ws_size, hipStream_t stream) {
    static int grid = 0;
    if (grid == 0) {
        if (n_in != 17 || in_sizes[0] != MP * DM || out_size != (int)OUT_END || ws_size < WS_END) {
            fprintf(stderr, "kernel_launch: unexpected shapes: n_in %d in0 %d out %d ws %zu (need %zu); nothing launched\n", n_in, n_in > 0 ? in_sizes[0] : -1, out_size, ws_size, (size_t)WS_END); grid = -1; return; }
        int dev = 0, cus = 0, per_cu = 0;
        if (hipGetDevice(&dev) != hipSuccess || hipDeviceGetAttribute(&cus, hipDeviceAttributeMultiprocessorCount, dev) != hipSuccess) { fprintf(stderr, "kernel_launch: device query failed\n"); grid = -1; return; }
        if (hipFuncSetAttribute((const void*)hymba_fwd, hipFuncAttributeMaxDynamicSharedMemorySize, LDS_BYTES) != hipSuccess) { fprintf(stderr, "kernel_launch: hipFuncSetAttribute failed\n"); grid = -1; return; }
        if (hipOccupancyMaxActiveBlocksPerMultiprocessor(&per_cu, (const void*)hymba_fwd, 512, LDS_BYTES) != hipSuccess || per_cu < 1)
            fprintf(stderr, "kernel_launch: note: occupancy query reports %d workgroups per CU\n", per_cu);
        (void)hipGetLastError();
        grid = cus;
        if (cus < 256) fprintf(stderr, "kernel_launch: built for a 256-CU device (P4 / P6 keep one GEMM unit per workgroup); %d CUs reported\n", cus);
    }
    if (grid < 0) return;
    if (hipMemsetAsync((char*)d_ws + WS_CTL, 0, CTL_ZERO_BYTES, stream) != hipSuccess) { fprintf(stderr, "kernel_launch: memset failed\n"); return; }
    Args a{};
    for (int i = 0; i < 17; ++i) a.in[i] = (const float*)d_in[i];
    a.out = (float*)d_out; a.ws = (unsigned char*)d_ws;
    if (PROBE_LO >= 0) {
        const int lo3[3] = {0, PROBE_LO, PROBE_HI}, hi3[3] = {PROBE_HI, PROBE_HI, NPH};
        for (int li = 0; li < 3; ++li) { a.ph_lo = lo3[li]; a.ph_hi = hi3[li]; a.li = li; a.pad = (li == 1) ? PROBE_SKIP : 0; if (a.ph_lo < a.ph_hi) hipLaunchKernelGGL(hymba_fwd, dim3(grid), dim3(512), LDS_BYTES, stream, a); }
        return;
    }
    for (int li = 0; li < MK_N_LAUNCHES; ++li) {
        if (MK_N_LAUNCHES == 1) { a.ph_lo = 0; a.ph_hi = NPH; } else { a.ph_lo = li; a.ph_hi = li + 1; }
        a.li = 0;
        hipLaunchKernelGGL(hymba_fwd, dim3(grid), dim3(512), LDS_BYTES, stream, a);
        const hipError_t le = hipPeekAtLastError();
        if (le != hipSuccess) { fprintf(stderr, "kernel_launch: launch %d failed: %s\n", li, hipGetErrorName(le)); break; }
    }
}
```
